# Optimizing an MI355X kernel written in HIP

```python
import jax, jax.numpy as jnp
from jax import lax
import numpy as np

D_MODEL = 2048
BATCH = 2
SEQ = 4096
DEPTH = 2

N_SB_HEADS = 8
SB_HEAD_DIM = 128
SB_WIDTH = N_SB_HEADS * SB_HEAD_DIM
Q_BLOCK = 128
N_SG_GROUPS = 8
SG_GROUP_DIM = 128
SG_WIDTH = N_SG_GROUPS * SG_GROUP_DIM
SG_CHUNK = 128
D_FF_DENSE = 5632
N_EXPERTS = 8
TOP_K = 2
D_FF_EXPERT = 7168
N_MOD = 6
EPS = 1e-6
N_DENSE_LAYERS = (DEPTH + 1) // 2
N_MOE_LAYERS = DEPTH // 2
IN_COLS = 3 * SB_WIDTH + 2 * SG_WIDTH + 2 * D_MODEL
IN_SPLITS = (SB_WIDTH, 2 * SB_WIDTH, 3 * SB_WIDTH, 3 * SB_WIDTH + SG_WIDTH,
             3 * SB_WIDTH + 2 * SG_WIDTH, 3 * SB_WIDTH + 2 * SG_WIDTH + D_MODEL)

kernel_name = "hybrid_stickbreak_spatialgate_moe_adaln"


def rmsnorm(x, g):
    xf = x.astype(jnp.float32)
    y = xf * lax.rsqrt(jnp.mean(xf * xf, axis=-1, keepdims=True) + EPS)
    return y.astype(x.dtype) * g


def stick_breaking_attention(q, k, v):
    S = q.shape[2]
    scale = SB_HEAD_DIM ** -0.5
    outs = []
    for t0 in range(0, S, Q_BLOCK):
        t1 = t0 + Q_BLOCK
        qb = q[:, :, t0:t1]
        kb = k[:, :, :t1]
        vb = v[:, :, :t1]
        z = jnp.einsum('bhqd,bhkd->bhqk', qb, kb).astype(jnp.float32) * scale
        q_pos = t0 + jnp.arange(Q_BLOCK)[:, None]
        k_pos = jnp.arange(t1)[None, :]
        mask = k_pos < q_pos
        log_beta = jnp.where(mask, jax.nn.log_sigmoid(z), -jnp.inf)
        log_1m_beta = jnp.where(mask, jax.nn.log_sigmoid(-z), 0.0)
        log_rest = lax.cumsum(log_1m_beta, axis=3, reverse=True) - log_1m_beta
        w = jnp.exp(log_beta + log_rest)
        outs.append(jnp.einsum('bhqk,bhkd->bhqd', w.astype(vb.dtype), vb))
    return jnp.concatenate(outs, axis=2)


def chunked_spatial_gating(u, vs, sg_norm_g, w_s, b_s):
    B, S, _ = u.shape
    vs = rmsnorm(vs, sg_norm_g)
    vs = vs.reshape(B, S // SG_CHUNK, SG_CHUNK, N_SG_GROUPS, SG_GROUP_DIM)
    causal = jnp.tril(jnp.ones((SG_CHUNK, SG_CHUNK), dtype=bool))
    w = jnp.where(causal[None], w_s, jnp.zeros_like(w_s))
    mixed = jnp.einsum('gts,bnsgc->bntgc', w, vs) + b_s.T[None, None, :, :, None]
    return u * mixed.reshape(B, S, SG_WIDTH)


def hybrid_mixer(h, w_in, q_norm_g, k_norm_g, sg_norm_g, w_s, b_s, w_proj_sb, w_proj_sg, w_out):
    B, S, _ = h.shape
    p = h @ w_in
    q, k, v, su, sv, ga, gb = jnp.split(p, IN_SPLITS, axis=-1)
    heads = lambda t: t.reshape(B, S, N_SB_HEADS, SB_HEAD_DIM)
    q = rmsnorm(heads(q), q_norm_g).transpose(0, 2, 1, 3)
    k = rmsnorm(heads(k), k_norm_g).transpose(0, 2, 1, 3)
    v = heads(v).transpose(0, 2, 1, 3)
    y_sb = stick_breaking_attention(q, k, v).transpose(0, 2, 1, 3).reshape(B, S, SB_WIDTH)
    y_sg = chunked_spatial_gating(jax.nn.gelu(su), jax.nn.gelu(sv), sg_norm_g, w_s, b_s)
    merged = jax.nn.sigmoid(ga) * (y_sb @ w_proj_sb) + jax.nn.sigmoid(gb) * (y_sg @ w_proj_sg)
    return merged @ w_out


def dense_swiglu(h, w1, w3, w2):
    return (jax.nn.silu(h @ w1) * (h @ w3)) @ w2


def moe_swiglu(h, w_router, w1, w3, w2):
    B, S, D = h.shape
    t = h.reshape(B * S, D)
    logits = (t @ w_router).astype(jnp.float32)
    top_val, top_idx = lax.top_k(logits, TOP_K)
    top_w = jax.nn.softmax(top_val, axis=-1)
    gates = jnp.sum(jax.nn.one_hot(top_idx, N_EXPERTS, dtype=jnp.float32) * top_w[..., None], axis=1)
    gates = gates.astype(t.dtype)
    out = jnp.zeros_like(t)
    for e in range(N_EXPERTS):
        he = jax.nn.silu(t @ w1[e]) * (t @ w3[e])
        out = out + gates[:, e:e + 1] * (he @ w2[e])
    return out.reshape(B, S, D)


def setup_inputs(seed: int = 0) -> dict:
    key = jax.random.key(seed)
    ks = iter(jax.random.split(key, 32))
    nrm = lambda shape, std: jax.random.normal(next(ks), shape, jnp.float32) * std
    D = D_MODEL
    return {
        "x": nrm((BATCH, SEQ, D), 1.0),
        "c": nrm((BATCH, D), 1.0),
        "w_ada": nrm((DEPTH, D, N_MOD * D), 0.5 * D ** -0.5),
        "b_ada": nrm((DEPTH, N_MOD * D), 0.02),
        "norm1_g": 1.0 + nrm((DEPTH, D), 0.02),
        "norm2_g": 1.0 + nrm((DEPTH, D), 0.02),
        "w_in": nrm((DEPTH, D, IN_COLS), D ** -0.5),
        "q_norm_g": 1.0 + nrm((DEPTH, SB_HEAD_DIM), 0.02),
        "k_norm_g": 1.0 + nrm((DEPTH, SB_HEAD_DIM), 0.02),
        "sg_norm_g": 1.0 + nrm((DEPTH, SG_WIDTH), 0.02),
        "w_s": nrm((DEPTH, N_SG_GROUPS, SG_CHUNK, SG_CHUNK), 0.5 * SG_CHUNK ** -0.5),
        "b_s": 1.0 + nrm((DEPTH, N_SG_GROUPS, SG_CHUNK), 0.02),
        "w_proj_sb": nrm((DEPTH, SB_WIDTH, D), SB_WIDTH ** -0.5),
        "w_proj_sg": nrm((DEPTH, SG_WIDTH, D), SG_WIDTH ** -0.5),
        "w_out": nrm((DEPTH, D, D), D ** -0.5),
        "ffn_w1": nrm((N_DENSE_LAYERS, D, D_FF_DENSE), D ** -0.5),
        "ffn_w3": nrm((N_DENSE_LAYERS, D, D_FF_DENSE), D ** -0.5),
        "ffn_w2": nrm((N_DENSE_LAYERS, D_FF_DENSE, D), D_FF_DENSE ** -0.5),
        "moe_router": nrm((N_MOE_LAYERS, D, N_EXPERTS), D ** -0.5),
        "moe_w1": nrm((N_MOE_LAYERS, N_EXPERTS, D, D_FF_EXPERT), D ** -0.5),
        "moe_w3": nrm((N_MOE_LAYERS, N_EXPERTS, D, D_FF_EXPERT), D ** -0.5),
        "moe_w2": nrm((N_MOE_LAYERS, N_EXPERTS, D_FF_EXPERT, D), D_FF_EXPERT ** -0.5),
    }


def reference(x, c, w_ada, b_ada, norm1_g, norm2_g, w_in, q_norm_g, k_norm_g, sg_norm_g,
              w_s, b_s, w_proj_sb, w_proj_sg, w_out, ffn_w1, ffn_w3, ffn_w2,
              moe_router, moe_w1, moe_w3, moe_w2):
    c_act = jax.nn.silu(c)
    for i in range(DEPTH):
        mod = (c_act @ w_ada[i] + b_ada[i])[:, None, :]
        shift1, scale1, gate1, shift2, scale2, gate2 = jnp.split(mod, N_MOD, axis=-1)
        h = rmsnorm(x, norm1_g[i]) * (1.0 + scale1) + shift1
        x = x + gate1 * hybrid_mixer(h, w_in[i], q_norm_g[i], k_norm_g[i], sg_norm_g[i],
                                     w_s[i], b_s[i], w_proj_sb[i], w_proj_sg[i], w_out[i])
        h = rmsnorm(x, norm2_g[i]) * (1.0 + scale2) + shift2
        if i % 2 == 0:
            j = i // 2
            f = dense_swiglu(h, ffn_w1[j], ffn_w3[j], ffn_w2[j])
        else:
            j = i // 2
            f = moe_swiglu(h, moe_router[j], moe_w1[j], moe_w3[j], moe_w2[j])
        x = x + gate2 * f
    return x
```

```cpp
#include <hip/hip_runtime.h>
#include <cstdio>
#include <cstdint>

#ifndef MK_PER_PHASE
#define MK_PER_PHASE 0
#endif
#ifndef FFN0_F8
#define FFN0_F8 0
#endif
#ifndef PROBE_GSITE
#define PROBE_GSITE 0
#endif
#define GSH(s) ((PROBE_GSITE >> (s)) & 1)
#ifndef PROBE_EPI
#define PROBE_EPI 0
#endif
#ifndef PROBE_REPEAT
#define PROBE_REPEAT 0
#endif

#define LAS __attribute__((address_space(3)))
#define GAS __attribute__((address_space(1)))
typedef unsigned short bf16_t;
typedef short bf16x8 __attribute__((ext_vector_type(8)));
typedef short s16x4 __attribute__((ext_vector_type(4)));
typedef float f32x2 __attribute__((ext_vector_type(2)));
typedef float f32x4 __attribute__((ext_vector_type(4)));
typedef float f32x16 __attribute__((ext_vector_type(16)));
typedef unsigned u32x2 __attribute__((ext_vector_type(2)));
typedef unsigned u32x4 __attribute__((ext_vector_type(4)));

constexpr int NB = 2, SEQ = 4096, T = NB * SEQ, D = 2048, NH = 8, HD = 128, SBW = 1024, SGW = 1024;
constexpr int NIN = 3 * SBW + 2 * SGW + 2 * D;
constexpr int FD = 5632, FE = 7168, NE = 8, NL = 2, NMOD = 6;
constexpr float EPS = 1e-6f;
constexpr float LOG2E = 1.4426950408889634f;
constexpr float QSCALE = 0.08838834764831845f * LOG2E;

constexpr size_t MiB = (size_t)1 << 20;
constexpr size_t WS_CTL = 0, CTL_ZERO_BYTES = 1 * MiB;
constexpr size_t WS_MOD = 1 * MiB;
constexpr size_t WS_RSVS = 2 * MiB;
constexpr size_t WS_ROUTE = 3 * MiB;
constexpr size_t WS_WSB = 4 * MiB;
constexpr size_t WS_WIN = 8 * MiB;
constexpr size_t WS_WPSB = 80 * MiB;
constexpr size_t WS_WPSG = 88 * MiB;
constexpr size_t WS_WOUT = 96 * MiB;
constexpr size_t WS_WF13 = 112 * MiB;
constexpr size_t WS_WF2 = 156 * MiB;
constexpr size_t WS_WM13 = 178 * MiB;
constexpr size_t WS_WM2 = 626 * MiB;
constexpr size_t WS_HN = 850 * MiB;
constexpr size_t WS_Q = 882 * MiB, WS_K = 898 * MiB, WS_V = 914 * MiB, WS_U = 930 * MiB, WS_VS = 946 * MiB;
constexpr size_t WS_GA = 962 * MiB, WS_GB = 994 * MiB;
constexpr size_t WS_YSB = 1026 * MiB, WS_YSG = 1042 * MiB;
constexpr size_t WS_MRG = 1058 * MiB;
constexpr size_t WS_TMPF = 1090 * MiB;
constexpr size_t WS_X1 = 1154 * MiB;
constexpr size_t WS_X2 = 1218 * MiB;
constexpr size_t WS_HID = 1282 * MiB;
constexpr size_t WS_HIDM = 1370 * MiB;
constexpr size_t WS_YM = 1622 * MiB;
constexpr size_t WS_HN8 = 1766 * MiB;
constexpr size_t WS_END = 1782 * MiB;
static_assert(WS_K - WS_Q == 16 * MiB && WS_V - WS_K == 16 * MiB && WS_U - WS_V == 16 * MiB && WS_VS - WS_U == 16 * MiB && WS_GB - WS_GA == 32 * MiB, "EpiInProj strides");
constexpr float WI8_SCALE = 1024.0f;
constexpr size_t WS_RS8 = 2 * MiB + 512 * 1024;
constexpr size_t WS_RS8A = 2 * MiB + 768 * 1024;
constexpr size_t WS_HN8A = WS_HN;
constexpr float W8_SCALE = 256.0f, HID8_SCALE = 8.0f;
constexpr int MOE_ROWS = 2 * T + NE * 256;
constexpr int MAXRT = MOE_ROWS / 256;
constexpr int CW_TMO = 0, CW_P0CTR = 64, CW_BAR = 4096, CW_CNT = 8192, CW_DYN = 12288;

constexpr int RING_BYTES = 131072;
constexpr int LDSCTL_OFF = RING_BYTES, MISC_OFF = LDSCTL_OFF + 320, MOETAB_OFF = LDSCTL_OFF + 1024, EPISCR_OFF = LDSCTL_OFF + 4096;
constexpr int RS_OFF = EPISCR_OFF + 8192;
constexpr int LDS_BYTES = 147456;
static_assert(RS_OFF + 2048 <= LDS_BYTES, "LDS map");
constexpr int NWAVES = 8, NTHREADS = NWAVES * 64;

typedef __bf16 bf16x2_t __attribute__((ext_vector_type(2)));
__device__ __forceinline__ unsigned cvt_pk_bf16(float lo, float hi) { const f32x2 v = {lo, hi}; const bf16x2_t b = __builtin_convertvector(v, bf16x2_t); return __builtin_bit_cast(unsigned, b); }
__device__ __forceinline__ float bf_lo(unsigned w) { return __uint_as_float(w << 16); }
__device__ __forceinline__ float bf_hi(unsigned w) { return __uint_as_float(w & 0xffff0000u); }
__device__ __forceinline__ float fexp2(float x) { return __builtin_amdgcn_exp2f(x); }
__device__ __forceinline__ float frcp(float x) { return __builtin_amdgcn_rcpf(x); }
__device__ __forceinline__ float sigmoid_f(float x) { return frcp(1.0f + fexp2(-LOG2E * x)); }
__device__ __forceinline__ float silu_f(float x) { return x * sigmoid_f(x); }
__device__ __forceinline__ float gelu_tanh_f(float x) { const float t = x * (1.0f + 0.044715f * x * x); return x * frcp(1.0f + fexp2(-2.3022082f * t)); }
__device__ __forceinline__ float wave_sum(float v) {
#pragma unroll
    for (int o = 1; o < 64; o <<= 1) v += __shfl_xor(v, o);
    return v;
}
#define LDS_WAIT() asm volatile("s_waitcnt lgkmcnt(0)" ::: "memory")
#define VM_WAIT() asm volatile("s_waitcnt vmcnt(0)" ::: "memory")
#define RLX_AGENT __ATOMIC_RELAXED, __HIP_MEMORY_SCOPE_AGENT

#define XB_TMO      128
#define XB_XCNT(j)  (256  + 64 * (j))
#define XB_XSUB(j)  (1280 + 64 * (j))
#define XB_XGEN(j)  (2304 + 64 * (j))
#define XB_TOP      3328
#define XB_TOPGEN   3392
#define XCD_BAR_WORDS 3456
#define XB_SPIN_CAP (1u << 18)
__device__ __forceinline__ unsigned xb_ld(unsigned* p)              { return __hip_atomic_load(p, __ATOMIC_RELAXED, __HIP_MEMORY_SCOPE_AGENT); }
__device__ __forceinline__ unsigned xb_add(unsigned* p, unsigned v) { return __hip_atomic_fetch_add(p, v, __ATOMIC_RELAXED, __HIP_MEMORY_SCOPE_AGENT); }
__device__ __forceinline__ unsigned xb_xcc_id() { return (unsigned)__builtin_amdgcn_s_getreg((3 << 11) | 20) & 0xFu; }
#define XB_SPIN(cond, bar) do { unsigned _sp = 0; while (cond) { __builtin_amdgcn_s_sleep(1); \
    if ((++_sp & 255u) == 0u) { if (xb_ld(&(bar)[XB_TMO])) break; if (_sp > XB_SPIN_CAP) { atomicAdd(&(bar)[XB_TMO], 1u); break; } } } } while (0)
struct XcdBarrier { unsigned* bar; unsigned x; volatile LAS unsigned* st; };
__device__ __forceinline__ XcdBarrier xcd_barrier_post(unsigned* bar, volatile LAS unsigned* st) {
    XcdBarrier b; b.bar = bar; b.x = xb_xcc_id(); b.st = st;
    if (threadIdx.x == 0) (void)xb_add(&bar[XB_XCNT(b.x)], 1u);
    return b;
}
__device__ __forceinline__ void xcd_barrier_complete(unsigned* bar, unsigned x, unsigned& nloc, unsigned& nx) {
    const unsigned G = gridDim.x * gridDim.y * gridDim.z;
    unsigned sum, cnt, mine, sp = 0u;
    for (;;) {
        sum = 0u; cnt = 0u; mine = 0u;
#pragma unroll
        for (unsigned j = 0; j < 16; ++j) { const unsigned c = xb_ld(&bar[XB_XCNT(j)]); sum += c; cnt += (c > 0u) ? 1u : 0u; mine = (j == x) ? c : mine; }
        if (sum == G) break;
        __builtin_amdgcn_s_sleep(1);
        if ((++sp & 255u) == 0u) { if (xb_ld(&bar[XB_TMO])) break; if (sp > XB_SPIN_CAP) { atomicAdd(&bar[XB_TMO], 1u); break; } }
    }
    nloc = mine > 0u ? mine : 1u; nx = cnt > 0u ? cnt : 1u;
}
__device__ __forceinline__ void xcd_barrier(const XcdBarrier& b) {
    asm volatile("s_waitcnt vmcnt(0)" ::: "memory");
    __syncthreads();
    if (threadIdx.x == 0) {
        unsigned* bar = b.bar;
        __builtin_amdgcn_s_waitcnt(0);
        unsigned nloc = b.st[0], nx = b.st[1];
        if (nloc == 0u) { xcd_barrier_complete(bar, b.x, nloc, nx); b.st[0] = nloc; b.st[1] = nx; }
        const unsigned old = xb_add(&bar[XB_XSUB(b.x)], 1u);
        const unsigned gen = old / nloc;
        if (old + 1u == (gen + 1u) * nloc) {
            __builtin_amdgcn_fence(__ATOMIC_RELEASE, "agent");
            asm volatile("s_waitcnt vmcnt(0)" ::: "memory");
            const unsigned og = xb_add(&bar[XB_TOP], 1u);
            const unsigned tg = og / nx;
            if (og + 1u == (tg + 1u) * nx) xb_add(&bar[XB_TOPGEN], 1u);
            else XB_SPIN(xb_ld(&bar[XB_TOPGEN]) == tg, bar);
            __builtin_amdgcn_fence(__ATOMIC_ACQUIRE, "agent");
            xb_add(&bar[XB_XGEN(b.x)], 1u);
            asm volatile("s_waitcnt vmcnt(0)" ::: "memory");
        } else {
            XB_SPIN(xb_ld(&bar[XB_XGEN(b.x)]) == gen, bar);
            __builtin_amdgcn_fence(__ATOMIC_ACQUIRE, "agent");
            asm volatile("s_waitcnt vmcnt(0)" ::: "memory");
        }
    }
    __syncthreads();
}

namespace pg8 {
constexpr int BM = 256, BK = 64, HALF = 128, HTB = HALF * BK * 2, STAGE_BYTES = 8 * HTB, NXCD = 8, WGM = 8;
__host__ __device__ __forceinline__ int lds_byte(int r, int c) { const int st = (r >> 4) * 2 + (c >> 5), rr = r & 15, cc = c & 31, ob = rr * 64 + cc * 2; return st * 1024 + (ob ^ (((ob >> 9) & 1) << 5)); }
__host__ __device__ __forceinline__ void stage_rc(int b, int& R, int& C) { const int st = b / 1024, sb = b % 1024, swz = sb ^ (((sb >> 9) & 1) << 5); R = (st >> 1) * 16 + swz / 64; C = (st & 1) * 32 + (swz % 64) / 2; }

struct Unit { int pm, pn, aux, nvalid; const char* A; const char* B; const int* rows; int nt, part, rsb; };

__device__ __forceinline__ void tile_of(int L, int nM, int nN, int& pm, int& pn) {
    const int nwg = nM * nN;
    int wgid = L; { const int q = nwg / NXCD, r = nwg % NXCD, xcd = wgid % NXCD, off = wgid / NXCD; wgid = (xcd < r ? xcd * (q + 1) : r * (q + 1) + (xcd - r) * q) + off; }
    const int nig = WGM * nN, gid = wgid / nig, fm = gid * WGM, gsz = (nM - fm) < WGM ? (nM - fm) : WGM;
    pm = fm + ((wgid % nig) % gsz); pn = (wgid % nig) / gsz;
}
__device__ __forceinline__ bool tile_order(int i, int G, int c, int nM, int nN, int& pm, int& pn) {
    const int nwg = nM * nN; const long L = (long)i * G + c; if (L >= nwg) return false;
    int wgid = (int)L; { const int q = nwg / NXCD, r = nwg % NXCD, xcd = wgid % NXCD, off = wgid / NXCD; wgid = (xcd < r ? xcd * (q + 1) : r * (q + 1) + (xcd - r) * q) + off; }
    const int nig = WGM * nN, gid = wgid / nig, fm = gid * WGM, gsz = (nM - fm) < WGM ? (nM - fm) : WGM;
    pm = fm + ((wgid % nig) % gsz); pn = (wgid % nig) / gsz; return true;
}

typedef int i32x4 __attribute__((ext_vector_type(4)));
typedef int i32x8 __attribute__((ext_vector_type(8)));
__device__ __forceinline__ i32x8 cat8(bf16x8 a, bf16x8 b) { const i32x4 x = __builtin_bit_cast(i32x4, a), y = __builtin_bit_cast(i32x4, b); return __builtin_shufflevector(x, y, 0, 1, 2, 3, 4, 5, 6, 7); }
__device__ __forceinline__ void glds16s(const char* sbase, unsigned voff, unsigned lds_dst) { unsigned keep;
    asm volatile("s_mov_b32 %0, m0\n\ts_mov_b32 m0, %3\n\ts_nop 0\n\tglobal_load_lds_dwordx4 %1, %2\n\ts_mov_b32 m0, %0" : "=&s"(keep) : "v"(voff), "s"(sbase), "s"(lds_dst) : "memory"); }
__device__ __forceinline__ void glds4s(const char* sbase, unsigned voff, unsigned lds_dst) { unsigned keep;
    asm volatile("s_mov_b32 %0, m0\n\ts_mov_b32 m0, %3\n\ts_nop 0\n\tglobal_load_lds_dword %1, %2\n\ts_mov_b32 m0, %0" : "=&s"(keep) : "v"(voff), "s"(sbase), "s"(lds_dst) : "memory"); }
__device__ __forceinline__ void mfma8(f32x4& acc, const i32x8& a, const i32x8& b) { asm volatile("v_mfma_f32_16x16x128_f8f6f4 %0, %1, %2, %0" : "+v"(acc) : "v"(a), "v"(b)); }
template <bool GATHER>
__device__ __forceinline__ void mk_voff(const Unit& u, int RB, int R0, int R1, int C0, int C1, unsigned& v00, unsigned& v01, unsigned& v10, unsigned& v11) {
    int r00 = R0, r01 = R1, r10 = 128 + R0, r11 = 128 + R1;
    if (GATHER) {
        const int a = u.rows[r00], b = u.rows[r01], c = u.rows[r10], d = u.rows[r11];
        r00 = r00 < u.nvalid ? a : 0; r01 = r01 < u.nvalid ? b : 0; r10 = r10 < u.nvalid ? c : 0; r11 = r11 < u.nvalid ? d : 0;
    }
    v00 = (unsigned)(r00 * RB + 2 * C0); v01 = (unsigned)(r01 * RB + 2 * C1); v10 = (unsigned)(r10 * RB + 2 * C0); v11 = (unsigned)(r11 * RB + 2 * C1);
}

template <class Epi, class Sched, bool GATHER, int MODE = 0  >
__device__ __forceinline__ void gemm_phase(LAS unsigned char* lds, const int K, Sched& S, const Epi& E) {
    const int tid = threadIdx.x, wid = __builtin_amdgcn_readfirstlane(tid >> 6), lane = tid & 63, wr = wid >> 2, wc = wid & 3, fr = lane & 15, fq = lane >> 4;
    constexpr bool FP8 = MODE == 1;
    const int nt = K / 128;
    int R0, C0, R1, C1; stage_rc(tid * 16, R0, C0); stage_rc(tid * 16 + 8192, R1, C1);
    unsigned voffB[2]; voffB[0] = (unsigned)(R0 * K + 2 * C0); voffB[1] = (unsigned)(R1 * K + 2 * C1);
    const size_t kstep = (size_t)(BK * 2);
    const size_t hstepB = (size_t)HALF * K;
    const unsigned ldsw = (unsigned)wid * 1024u;
    const unsigned ldsbase = (unsigned)__builtin_amdgcn_readfirstlane((int)(unsigned)(uintptr_t)lds) + ldsw;
    const int aoff = lds_byte(wr * 64 + fr, fq * 8), boff = lds_byte(wc * 32 + fr, fq * 8);
#define PG8_SA(b, h) (((b) * 2 + (h)) * HTB)
#define PG8_SB(b, h) ((4 + (b) * 2 + (h)) * HTB)
#define PG8_STAGE2(bufoff, gbase, o0, o1) do { glds16s((gbase), (o0), ldsbase + (unsigned)(bufoff)); glds16s((gbase), (o1), ldsbase + (unsigned)(bufoff) + 8192u); } while (0)
#define PG8_STAGE_B(bufoff, gbase) PG8_STAGE2(bufoff, gbase, voffB[0], voffB[1])
#define PG8_LDA(dst, b, h) do { if constexpr (FP8) { _Pragma("unroll") for (int m = 0; m < 4; ++m) dst##8[m] = cat8(*(const LAS bf16x8*)(lds + PG8_SA(b, h) + aoff + m * 2048), *(const LAS bf16x8*)(lds + PG8_SA(b, h) + aoff + m * 2048 + 1024)); } \
        else { _Pragma("unroll") for (int m = 0; m < 4; ++m) _Pragma("unroll") for (int k = 0; k < 2; ++k) dst[m][k] = *(const LAS bf16x8*)(lds + PG8_SA(b, h) + aoff + m * 2048 + k * 1024); } } while (0)
#define PG8_LDB(dst, b, h) do { if constexpr (FP8) { _Pragma("unroll") for (int n = 0; n < 2; ++n) dst##8[n] = cat8(*(const LAS bf16x8*)(lds + PG8_SB(b, h) + boff + n * 2048), *(const LAS bf16x8*)(lds + PG8_SB(b, h) + boff + n * 2048 + 1024)); } \
        else { _Pragma("unroll") for (int n = 0; n < 2; ++n) _Pragma("unroll") for (int k = 0; k < 2; ++k) dst[n][k] = *(const LAS bf16x8*)(lds + PG8_SB(b, h) + boff + n * 2048 + k * 1024); } } while (0)
#define PG8_MMA(ai, bj, At, Bt) do { __builtin_amdgcn_s_setprio(1); _Pragma("unroll") for (int m = 0; m < 4; ++m) _Pragma("unroll") for (int n = 0; n < 2; ++n) { \
        if constexpr (FP8) { mfma8(acc[ai][bj][m][n], Bt##8[n], At##8[m]); } \
        else if constexpr (MODE == 2) { _Pragma("unroll") for (int k = 0; k < 2; ++k) acc[ai][bj][m][n] = __builtin_bit_cast(f32x4, __builtin_amdgcn_mfma_i32_16x16x64_i8(__builtin_bit_cast(i32x4, Bt[n][k]), __builtin_bit_cast(i32x4, At[m][k]), __builtin_bit_cast(i32x4, acc[ai][bj][m][n]), 0, 0, 0)); } \
        else { _Pragma("unroll") for (int k = 0; k < 2; ++k) acc[ai][bj][m][n] = __builtin_amdgcn_mfma_f32_16x16x32_bf16(Bt[n][k], At[m][k], acc[ai][bj][m][n], 0, 0, 0); } } \
        __builtin_amdgcn_s_setprio(0); } while (0)
#define PG8_WAIT_V(n) asm volatile("s_waitcnt vmcnt(" #n ")" ::: "memory")
#define PG8_WAIT_L(n) asm volatile("s_waitcnt lgkmcnt(" #n ")" ::: "memory")
#define PG8_BAR __builtin_amdgcn_s_barrier()
#define PG8_SCHED __builtin_amdgcn_sched_barrier(0)
    Unit cur, nxt; int ui = 0;
    if (!S.next(0, cur)) return;
    f32x4 acc[2][2][4][2];
#pragma unroll
    for (int a = 0; a < 2; ++a)
#pragma unroll
        for (int b = 0; b < 2; ++b)
#pragma unroll
            for (int m = 0; m < 4; ++m)
#pragma unroll
                for (int n = 0; n < 2; ++n) acc[a][b][m][n] = (f32x4){0.f, 0.f, 0.f, 0.f};
    bf16x8 At[4][2], B0[2][2], B1[2][2]; i32x8 At8[4], B08[2], B18[2];
    const char* cA = cur.A; const char* cB = cur.B;
    unsigned c00, c01, c10, c11;
    mk_voff<GATHER>(cur, K, R0, R1, C0, C1, c00, c01, c10, c11);
#define PG8_RS(un, par) do { if constexpr (Epi::RSLDS) { un.rsb = (par) * 256; if (wid < 4) glds4s((const char*)E.scale_src(un), (unsigned)(tid * 4), ldsbase - ldsw + (unsigned)RS_OFF + (unsigned)(par) * 1024u + (unsigned)wid * 256u); } } while (0)
    PG8_RS(cur, 0);
    PG8_STAGE_B(PG8_SB(0, 0), cB); PG8_STAGE_B(PG8_SB(0, 1), cB + hstepB); PG8_STAGE2(PG8_SA(0, 0), cA, c00, c01); PG8_STAGE2(PG8_SA(0, 1), cA, c10, c11);
    if (wr == 1) PG8_BAR;
    PG8_WAIT_V(2); PG8_BAR;
    PG8_STAGE_B(PG8_SB(1, 0), cB + kstep); PG8_STAGE2(PG8_SA(1, 0), cA + kstep, c00, c01); PG8_STAGE_B(PG8_SB(1, 1), cB + hstepB + kstep);
    PG8_WAIT_V(6); PG8_BAR;
    for (;;) {
        const bool has_next = S.next(ui + 1, nxt);
        const char* nA = has_next ? nxt.A : cA; const char* nB = has_next ? nxt.B : cB;
        unsigned n00 = c00, n01 = c01, n10 = c10, n11 = c11;
        if (GATHER) { if (has_next) mk_voff<GATHER>(nxt, K, R0, R1, C0, C1, n00, n01, n10, n11); }
        int ntc = nt; if constexpr (Sched::VARK) ntc = cur.nt;
        for (int t = 0; t < ntc; t += 2) {
            const bool last = (t == ntc - 2);
            const char* a1 = cA + (size_t)(t + 1) * kstep;
            const char* a2 = last ? nA : cA + (size_t)(t + 2) * kstep; const char* b2 = last ? nB : cB + (size_t)(t + 2) * kstep;
            const char* a3 = a2 + kstep; const char* b3 = b2 + kstep;
            unsigned s00 = c00, s01 = c01, s10 = c10, s11 = c11;
            if (GATHER) { s00 = last ? n00 : c00; s01 = last ? n01 : c01; s10 = last ? n10 : c10; s11 = last ? n11 : c11; }
            PG8_LDB(B0, 0, 0); PG8_LDB(B1, 0, 1); PG8_SCHED; PG8_LDA(At, 0, 0); PG8_STAGE2(PG8_SA(1, 1), a1, c10, c11);
            PG8_WAIT_V(8); PG8_WAIT_L(0); PG8_BAR; PG8_MMA(0, 0, At, B0); PG8_MMA(0, 1, At, B1); PG8_BAR; PG8_SCHED;
            PG8_LDA(At, 0, 1); PG8_STAGE_B(PG8_SB(0, 0), b2); PG8_STAGE_B(PG8_SB(0, 1), b2 + hstepB); PG8_STAGE2(PG8_SA(0, 0), a2, s00, s01);
            PG8_WAIT_V(8); PG8_WAIT_L(0); PG8_BAR; PG8_MMA(1, 0, At, B0); PG8_MMA(1, 1, At, B1); PG8_BAR; PG8_SCHED;
            PG8_LDB(B0, 1, 0); PG8_LDB(B1, 1, 1); PG8_SCHED; PG8_LDA(At, 1, 0); PG8_STAGE2(PG8_SA(0, 1), a2, s10, s11);
            PG8_WAIT_V(8); PG8_WAIT_L(0); PG8_BAR; PG8_MMA(0, 0, At, B0); PG8_MMA(0, 1, At, B1); PG8_BAR; PG8_SCHED;
            PG8_LDA(At, 1, 1); PG8_STAGE_B(PG8_SB(1, 0), b3); PG8_STAGE_B(PG8_SB(1, 1), b3 + hstepB); PG8_STAGE2(PG8_SA(1, 0), a3, s00, s01);
            PG8_WAIT_V(8); PG8_WAIT_L(0); PG8_BAR; PG8_MMA(1, 0, At, B0); PG8_MMA(1, 1, At, B1); PG8_BAR; PG8_SCHED;
        }
        if (wr == 0) PG8_BAR;
        if constexpr (FP8) asm volatile("s_nop 15\n\ts_nop 7" ::: "memory");
        E(acc, cur, wr, wc, fr, fq);
#if PROBE_EPI
        asm volatile("" ::: "memory"); E(acc, cur, wr, wc, fr, fq);
#endif
        if (!has_next) break;
#pragma unroll
        for (int a = 0; a < 2; ++a)
#pragma unroll
            for (int b = 0; b < 2; ++b)
#pragma unroll
                for (int m = 0; m < 4; ++m)
#pragma unroll
                    for (int n = 0; n < 2; ++n) acc[a][b][m][n] = (f32x4){0.f, 0.f, 0.f, 0.f};
        cur = nxt; cA = nA; cB = nB; ++ui;
        PG8_RS(cur, ui & 1);
        if (GATHER) { c00 = n00; c01 = n01; c10 = n10; c11 = n11; }
        if (wr == 1) PG8_BAR;
    }
    PG8_WAIT_V(0);
    PG8_BAR;
#undef PG8_RS
#undef PG8_SA
#undef PG8_SB
#undef PG8_STAGE2
#undef PG8_STAGE_B
#undef PG8_LDA
#undef PG8_LDB
#undef PG8_MMA
#undef PG8_WAIT_V
#undef PG8_WAIT_L
#undef PG8_BAR
#undef PG8_SCHED
}

struct DenseOrder {
    static constexpr bool VARK = false;
    const char* A; const char* B; int nM, nN, G, c; size_t tstepA, tstepB; int rsh;
    __device__ __forceinline__ bool next(int i, Unit& u) const {
        int pm, pn; if (!tile_order(i >> rsh, G, c, nM, nN, pm, pn)) return false;
        u.pm = pm; u.pn = pn; u.aux = 0; u.nvalid = 256; u.A = A + (size_t)pm * tstepA; u.B = B + (size_t)pn * tstepB; u.rows = nullptr; return true;
    }
};
struct PairOrder {
    static constexpr bool VARK = false;
    const char* A0; const char* B0; const char* A1; const char* B1; int nM, nN, G, c; size_t tstepA, tstepB; int rsh;
    __device__ __forceinline__ bool next(int i, Unit& u) const {
        int pm, pn; if (!tile_order(i >> (1 + rsh), G, c, nM, nN, pm, pn)) return false;
        const int w = i & 1;
        u.pm = pm; u.pn = pn; u.aux = w; u.nvalid = 256; u.A = (w ? A1 : A0) + (size_t)pm * tstepA; u.B = (w ? B1 : B0) + (size_t)pn * tstepB; u.rows = nullptr; return true;
    }
};
constexpr int DYN_PN0 = 24, DYN_NPN = 12, DYN_LIST = 4 * DYN_NPN;
struct DynOrder {
    static constexpr bool VARK = false;
    const char* A; const char* B; unsigned* cnt; volatile LAS int* word; int x, k; size_t tstepA, tstepB; int pn0; int budget, done;
    __device__ __forceinline__ bool next(int, Unit& u) {
        if (budget <= 0) return false;
        --budget;
        if (threadIdx.x < 64) {
            int v = -1;
            while (k < 8) { const int list = (x + k) & 7; int got = 0;
                if (threadIdx.x == 0) got = (int)__hip_atomic_fetch_add(cnt + 64 * list, 1u, RLX_AGENT);
                got = __builtin_amdgcn_readfirstlane(got);
                if (got < DYN_LIST) { v = list * 64 + got; break; }
                ++k; }
            if (threadIdx.x == 0) word[0] = v;
            asm volatile("s_waitcnt lgkmcnt(0)" ::: "memory");
        }
        asm volatile("" ::: "memory"); __builtin_amdgcn_s_barrier(); asm volatile("" ::: "memory");
        const int v = __builtin_amdgcn_readfirstlane(word[0]);
        if (v < 0) { done = 1; return false; }
        const int list = v >> 6, got = v & 63, pm = 4 * list + (got & 3), pn = pn0 + (got >> 2);
        u.pm = pm; u.pn = pn; u.aux = 0; u.nvalid = 256; u.A = A + (size_t)pm * tstepA; u.B = B + (size_t)pn * tstepB; u.rows = nullptr; return true;
    }
};
struct MoeSplitOrder {
    static constexpr bool VARK = true;
    const char* A; const char* B; const volatile LAS int* tab; int nN, G, c, NT; size_t tstepA, tstepB, estepB;
    __device__ __forceinline__ bool next(int i, Unit& u) const {
        const int nM = __builtin_amdgcn_readfirstlane(tab[8]), S = __builtin_amdgcn_readfirstlane(tab[9]), full = __builtin_amdgcn_readfirstlane(tab[10]);
        const int nwg = nM * nN, L = i * G + c;
        int unit = L, kp = 0, part = -1, ntu = NT;
        if (L >= full && S > 1) { const int j = L - full, tl = j / S; if (tl >= nwg - full) return false; unit = full + tl; kp = j - tl * S; ntu = NT / S; part = kp ? tl * (S - 1) + kp - 1 : -1; }
        else if (L >= nwg) return false;
        int pm, pn; tile_of(unit, nM, nN, pm, pn);
        const int e = __builtin_amdgcn_readfirstlane(tab[32 + pm]);
        u.pm = pm; u.pn = pn; u.aux = e; u.nvalid = 256; u.rows = nullptr; u.nt = ntu; u.part = part;
        u.A = A + (size_t)pm * tstepA + (size_t)(kp * ntu) * 128; u.B = B + (size_t)e * estepB + (size_t)pn * tstepB + (size_t)(kp * ntu) * 128;
        return true;
    }
};
struct MoeOrder {
    static constexpr bool VARK = false;
    const char* A; const char* B; const int* lists; const volatile LAS int* tab; int nN, G, c, gather; size_t tstepA, tstepB, estepB; int rsh;
    __device__ __forceinline__ bool next(int i, Unit& u) const {
        const int nM = __builtin_amdgcn_readfirstlane(tab[8]);
        int pm, pn; if (!tile_order(i >> rsh, G, c, nM, nN, pm, pn)) return false;
        const int e = __builtin_amdgcn_readfirstlane(tab[32 + pm]);
        const int lt = pm - __builtin_amdgcn_readfirstlane(tab[e]);
        const int cnt = __builtin_amdgcn_readfirstlane(tab[16 + e]);
        u.pm = pm; u.pn = pn; u.aux = e; u.B = B + (size_t)e * estepB + (size_t)pn * tstepB;
        if (gather) { u.A = A; u.rows = lists + (size_t)e * T + lt * 256; u.nvalid = cnt - lt * 256; }
        else { u.A = A + (size_t)pm * tstepA; u.rows = nullptr; u.nvalid = 256; }
        return true;
    }
};

template <bool I8> __device__ __forceinline__ f32x4 cvt_acc(const f32x4& a, float sc) {
    if constexpr (I8) { const i32x4 b = __builtin_bit_cast(i32x4, a); f32x4 r; r[0] = (float)b[0] * sc; r[1] = (float)b[1] * sc; r[2] = (float)b[2] * sc; r[3] = (float)b[3] * sc; return r; }
    else return a;
}
struct EpiInProj {
    static constexpr bool RSLDS = true;
    bf16_t *Q, *GA; const float* rowscale; const LAS float* rs_lds;
    __device__ __forceinline__ const float* scale_src(const Unit& u) const { return rowscale + u.pm * BM; }
    __device__ __forceinline__ void operator()(const f32x4 (&acc)[2][2][4][2], const Unit& u, int wr, int wc, int fr, int fq) const {
        const int q = u.pn - 20; bf16_t* base = GA + (size_t)(q >> 3) * (size_t)(16u << 20); const int colt = (q & 7) * 256;
        const int row0 = u.pm * BM + wr * 64 + fr, col0 = colt + wc * 32 + 8 * fq;
        float rsv[2][4];
#pragma unroll
        for (int ai = 0; ai < 2; ++ai)
#pragma unroll
            for (int m = 0; m < 4; ++m) rsv[ai][m] = rs_lds[u.rsb + wr * 64 + fr + ai * HALF + m * 16] * (1.0f / WI8_SCALE);
#pragma unroll
        for (int ai = 0; ai < 2; ++ai)
#pragma unroll
            for (int m = 0; m < 4; ++m) { bf16_t* rowp = base + (size_t)(row0 + ai * HALF + m * 16) * 2048 + col0; const float rs = rsv[ai][m];
#pragma unroll
                for (int bj = 0; bj < 2; ++bj) { f32x4 v0 = cvt_acc<true>(acc[ai][bj][m][0], rs), v1 = cvt_acc<true>(acc[ai][bj][m][1], rs);
#pragma unroll
                    for (int j = 0; j < 4; ++j) { v0[j] = sigmoid_f(v0[j]); v1[j] = sigmoid_f(v1[j]); }
                    u32x4 w; w.x = cvt_pk_bf16(v0[0], v0[1]); w.y = cvt_pk_bf16(v0[2], v0[3]); w.z = cvt_pk_bf16(v1[0], v1[1]); w.w = cvt_pk_bf16(v1[2], v1[3]);
                    *(u32x4*)(rowp + bj * HALF) = w; } }
    }
};
struct EpiInProj1 {
    static constexpr bool RSLDS = true;
    bf16_t *Q, *GA; const float *gq, *gk; float* SSQ; LAS float* scr; const float* rowscale; const LAS float* rs_lds;
    __device__ __forceinline__ const float* scale_src(const Unit& u) const { return rowscale + u.pm * BM; }
    __device__ __forceinline__ void operator()(const f32x4 (&acc)[2][2][4][2], const Unit& u, int wr, int wc, int fr, int fq) const {
        const int pn = u.pn;
        const int row0 = u.pm * BM + wr * 64 + fr;
        float rsv[2][4];
#pragma unroll
        for (int ai = 0; ai < 2; ++ai)
#pragma unroll
            for (int m = 0; m < 4; ++m) rsv[ai][m] = rs_lds[u.rsb + wr * 64 + fr + ai * HALF + m * 16] * (1.0f / WI8_SCALE);
#define ACCF(ai, bj, m, n) cvt_acc<true>(acc[ai][bj][m][n], rsv[ai][m])
        if (pn < 8) {
            const bool isq = pn < 4; const float* gv = (isq ? gq : gk) + wc * 32 + 8 * fq; const float mul = isq ? QSCALE : 1.0f;
            const f32x4 g0 = *(const f32x4*)gv, g1 = *(const f32x4*)(gv + 4);
            bf16_t* base = Q + (size_t)(pn >> 2) * (size_t)(8u << 20); const int col0 = (pn & 3) * 256 + wc * 32 + 8 * fq;
#pragma unroll
            for (int ai = 0; ai < 2; ++ai)
#pragma unroll
                for (int m = 0; m < 4; ++m)
#pragma unroll
                    for (int bj = 0; bj < 2; ++bj) { const f32x4 v0 = ACCF(ai, bj, m, 0), v1 = ACCF(ai, bj, m, 1);
                        float ss = (v0[0] * v0[0] + v0[1] * v0[1]) + (v0[2] * v0[2] + v0[3] * v0[3]) + (v1[0] * v1[0] + v1[1] * v1[1]) + (v1[2] * v1[2] + v1[3] * v1[3]);
                        ss += __shfl_xor(ss, 16); ss += __shfl_xor(ss, 32);
                        if (fq == 0) scr[(ai * HALF + wr * 64 + m * 16 + fr) * 8 + bj * 4 + wc] = ss; }
            asm volatile("s_waitcnt lgkmcnt(0)" ::: "memory"); __builtin_amdgcn_s_barrier(); asm volatile("" ::: "memory");
#pragma unroll
            for (int ai = 0; ai < 2; ++ai)
#pragma unroll
                for (int m = 0; m < 4; ++m) { bf16_t* rowp = base + (size_t)(row0 + ai * HALF + m * 16) * 1024 + col0;
#pragma unroll
                    for (int bj = 0; bj < 2; ++bj) { const f32x4 pp = *(const LAS f32x4*)(scr + (ai * HALF + wr * 64 + m * 16 + fr) * 8 + bj * 4);
                        const float rs = mul / sqrtf(((pp[0] + pp[1]) + (pp[2] + pp[3])) * (1.0f / HD) + EPS);
                        const f32x4 v0 = ACCF(ai, bj, m, 0) * rs * g0, v1 = ACCF(ai, bj, m, 1) * rs * g1;
                        u32x4 w; w.x = cvt_pk_bf16(v0[0], v0[1]); w.y = cvt_pk_bf16(v0[2], v0[3]); w.z = cvt_pk_bf16(v1[0], v1[1]); w.w = cvt_pk_bf16(v1[2], v1[3]);
                        *(u32x4*)(rowp + bj * HALF) = w; } }
        } else if (pn < 12) {
            bf16_t* base = Q + (size_t)2 * (size_t)(8u << 20); const int col0 = (pn & 3) * 256 + wc * 32 + 8 * fq;
#pragma unroll
            for (int ai = 0; ai < 2; ++ai)
#pragma unroll
                for (int m = 0; m < 4; ++m) { bf16_t* rowp = base + (size_t)(row0 + ai * HALF + m * 16) * 1024 + col0;
#pragma unroll
                    for (int bj = 0; bj < 2; ++bj) { const f32x4 v0 = ACCF(ai, bj, m, 0), v1 = ACCF(ai, bj, m, 1);
                        u32x4 w; w.x = cvt_pk_bf16(v0[0], v0[1]); w.y = cvt_pk_bf16(v0[2], v0[3]); w.z = cvt_pk_bf16(v1[0], v1[1]); w.w = cvt_pk_bf16(v1[2], v1[3]);
                        *(u32x4*)(rowp + bj * HALF) = w; } }
        } else if (pn < 20) {
            const bool isvs = pn >= 16; bf16_t* base = Q + (size_t)(pn >> 2) * (size_t)(8u << 20); const int col0 = (pn & 3) * 256 + wc * 32 + 8 * fq;
#pragma unroll
            for (int ai = 0; ai < 2; ++ai)
#pragma unroll
                for (int m = 0; m < 4; ++m) { bf16_t* rowp = base + (size_t)(row0 + ai * HALF + m * 16) * 1024 + col0; float ss = 0.f;
#pragma unroll
                    for (int bj = 0; bj < 2; ++bj) { f32x4 v0 = ACCF(ai, bj, m, 0), v1 = ACCF(ai, bj, m, 1);
#pragma unroll
                        for (int j = 0; j < 4; ++j) { v0[j] = gelu_tanh_f(v0[j]); v1[j] = gelu_tanh_f(v1[j]); }
                        ss += (v0[0] * v0[0] + v0[1] * v0[1]) + (v0[2] * v0[2] + v0[3] * v0[3]) + (v1[0] * v1[0] + v1[1] * v1[1]) + (v1[2] * v1[2] + v1[3] * v1[3]);
                        u32x4 w; w.x = cvt_pk_bf16(v0[0], v0[1]); w.y = cvt_pk_bf16(v0[2], v0[3]); w.z = cvt_pk_bf16(v1[0], v1[1]); w.w = cvt_pk_bf16(v1[2], v1[3]);
                        *(u32x4*)(rowp + bj * HALF) = w; }
                    if (isvs) { ss += __shfl_xor(ss, 16); ss += __shfl_xor(ss, 32); if (fq == 0) scr[(ai * HALF + wr * 64 + m * 16 + fr) * 8 + wc] = ss; } }
            if (isvs) {
                asm volatile("s_waitcnt lgkmcnt(0)" ::: "memory"); __builtin_amdgcn_s_barrier(); asm volatile("" ::: "memory");
                const int t = threadIdx.x;
                if (t < 256) { const f32x4 pp = *(const LAS f32x4*)(scr + t * 8); SSQ[(size_t)(u.pm * BM + t) * 4 + (pn - 16)] = (pp[0] + pp[1]) + (pp[2] + pp[3]); }
            }
        } else {
            const int q = pn - 20; bf16_t* base = GA; const int col0 = q * 256 + wc * 32 + 8 * fq;
#pragma unroll
            for (int ai = 0; ai < 2; ++ai)
#pragma unroll
                for (int m = 0; m < 4; ++m) { bf16_t* rowp = base + (size_t)(row0 + ai * HALF + m * 16) * 2048 + col0;
#pragma unroll
                    for (int bj = 0; bj < 2; ++bj) { f32x4 v0 = ACCF(ai, bj, m, 0), v1 = ACCF(ai, bj, m, 1);
#pragma unroll
                        for (int j = 0; j < 4; ++j) { v0[j] = sigmoid_f(v0[j]); v1[j] = sigmoid_f(v1[j]); }
                        u32x4 w; w.x = cvt_pk_bf16(v0[0], v0[1]); w.y = cvt_pk_bf16(v0[2], v0[3]); w.z = cvt_pk_bf16(v1[0], v1[1]); w.w = cvt_pk_bf16(v1[2], v1[3]);
                        *(u32x4*)(rowp + bj * HALF) = w; } }
        }
#undef ACCF
    }
};
struct EpiProjMerge {
    static constexpr bool RSLDS = false;
    const bf16_t *GA, *GB; float* TMP; bf16_t* MRG;
    __device__ __forceinline__ void operator()(const f32x4 (&acc)[2][2][4][2], const Unit& u, int wr, int wc, int fr, int fq) const {
        const int row0 = u.pm * BM + wr * 64 + fr, col0 = u.pn * BM + wc * 32 + 8 * fq;
        if (u.aux == 0) {
#pragma unroll
            for (int ai = 0; ai < 2; ++ai) {
              u32x4 gg[4][2];
#pragma unroll
              for (int m = 0; m < 4; ++m)
#pragma unroll
                for (int bj = 0; bj < 2; ++bj) gg[m][bj] = *(const u32x4*)(GA + (size_t)(row0 + ai * HALF + m * 16) * D + col0 + bj * HALF);
#pragma unroll
                for (int m = 0; m < 4; ++m) { const size_t off = (size_t)(row0 + ai * HALF + m * 16) * D + col0;
#pragma unroll
                    for (int bj = 0; bj < 2; ++bj) { const u32x4 g = gg[m][bj]; const f32x4 v0 = acc[ai][bj][m][0], v1 = acc[ai][bj][m][1];
                        f32x4 o0, o1; o0[0] = bf_lo(g.x) * v0[0]; o0[1] = bf_hi(g.x) * v0[1]; o0[2] = bf_lo(g.y) * v0[2]; o0[3] = bf_hi(g.y) * v0[3];
                        o1[0] = bf_lo(g.z) * v1[0]; o1[1] = bf_hi(g.z) * v1[1]; o1[2] = bf_lo(g.w) * v1[2]; o1[3] = bf_hi(g.w) * v1[3];
                        u32x4 w; w.x = cvt_pk_bf16(o0[0], o0[1]); w.y = cvt_pk_bf16(o0[2], o0[3]); w.z = cvt_pk_bf16(o1[0], o1[1]); w.w = cvt_pk_bf16(o1[2], o1[3]);
                        *(u32x4*)(MRG + off + bj * HALF) = w; } } }
        } else {
#pragma unroll
            for (int ai = 0; ai < 2; ++ai) {
              u32x4 gg[4][2], tt[4][2];
#pragma unroll
              for (int m = 0; m < 4; ++m)
#pragma unroll
                for (int bj = 0; bj < 2; ++bj) { const size_t o = (size_t)(row0 + ai * HALF + m * 16) * D + col0 + bj * HALF; gg[m][bj] = *(const u32x4*)(GB + o); tt[m][bj] = *(const u32x4*)(MRG + o); }
#pragma unroll
                for (int m = 0; m < 4; ++m) { const size_t off = (size_t)(row0 + ai * HALF + m * 16) * D + col0;
#pragma unroll
                    for (int bj = 0; bj < 2; ++bj) { const u32x4 g = gg[m][bj]; const f32x4 v0 = acc[ai][bj][m][0], v1 = acc[ai][bj][m][1];
                        const u32x4 tw = tt[m][bj]; const f32x4 t0 = {bf_lo(tw.x), bf_hi(tw.x), bf_lo(tw.y), bf_hi(tw.y)}, t1 = {bf_lo(tw.z), bf_hi(tw.z), bf_lo(tw.w), bf_hi(tw.w)};
                        f32x4 o0, o1; o0[0] = t0[0] + bf_lo(g.x) * v0[0]; o0[1] = t0[1] + bf_hi(g.x) * v0[1]; o0[2] = t0[2] + bf_lo(g.y) * v0[2]; o0[3] = t0[3] + bf_hi(g.y) * v0[3];
                        o1[0] = t1[0] + bf_lo(g.z) * v1[0]; o1[1] = t1[1] + bf_hi(g.z) * v1[1]; o1[2] = t1[2] + bf_lo(g.w) * v1[2]; o1[3] = t1[3] + bf_hi(g.w) * v1[3];
                        u32x4 w; w.x = cvt_pk_bf16(o0[0], o0[1]); w.y = cvt_pk_bf16(o0[2], o0[3]); w.z = cvt_pk_bf16(o1[0], o1[1]); w.w = cvt_pk_bf16(o1[2], o1[3]);
                        *(u32x4*)(MRG + off + bj * HALF) = w; } } }
        }
    }
};
template <bool BASE_BF> struct EpiResid {
    static constexpr bool RSLDS = false;
    const void* base; const float* gate; bf16_t* out; float scale;
    __device__ __forceinline__ void operator()(const f32x4 (&acc)[2][2][4][2], const Unit& u, int wr, int wc, int fr, int fq) const {
        const int row0 = u.pm * BM + wr * 64 + fr, col0 = u.pn * BM + wc * 32 + 8 * fq;
        const float* gv = gate + (size_t)(u.pm >> 4) * (NMOD * D) + col0;
        f32x4 g[2][2];
#pragma unroll
        for (int bj = 0; bj < 2; ++bj)
#pragma unroll
            for (int n = 0; n < 2; ++n) g[bj][n] = *(const f32x4*)(gv + bj * HALF + 4 * n);
#pragma unroll
        for (int ai = 0; ai < 2; ++ai) {
            f32x4 bs[4][2][2];
#pragma unroll
            for (int m = 0; m < 4; ++m)
#pragma unroll
                for (int bj = 0; bj < 2; ++bj) { const size_t o = (size_t)(row0 + ai * HALF + m * 16) * D + col0 + bj * HALF;
                    if constexpr (BASE_BF) { const u32x4 w = *(const u32x4*)((const bf16_t*)base + o); bs[m][bj][0] = (f32x4){bf_lo(w.x), bf_hi(w.x), bf_lo(w.y), bf_hi(w.y)}; bs[m][bj][1] = (f32x4){bf_lo(w.z), bf_hi(w.z), bf_lo(w.w), bf_hi(w.w)}; }
                    else { bs[m][bj][0] = *(const f32x4*)((const float*)base + o); bs[m][bj][1] = *(const f32x4*)((const float*)base + o + 4); } }
#pragma unroll
            for (int m = 0; m < 4; ++m)
#pragma unroll
                for (int bj = 0; bj < 2; ++bj) { const size_t o = (size_t)(row0 + ai * HALF + m * 16) * D + col0 + bj * HALF;
                    const f32x4 r0 = bs[m][bj][0] + g[bj][0] * (acc[ai][bj][m][0] * scale), r1 = bs[m][bj][1] + g[bj][1] * (acc[ai][bj][m][1] * scale);
                    u32x4 w; w.x = cvt_pk_bf16(r0[0], r0[1]); w.y = cvt_pk_bf16(r0[2], r0[3]); w.z = cvt_pk_bf16(r1[0], r1[1]); w.w = cvt_pk_bf16(r1[2], r1[3]); *(u32x4*)(out + o) = w; } }
    }
};
struct EpiStore32 {
    static constexpr bool RSLDS = false;
    float* out; int ldc; float scale;
    __device__ __forceinline__ void operator()(const f32x4 (&acc)[2][2][4][2], const Unit& u, int wr, int wc, int fr, int fq) const {
        const int row0 = u.pm * BM + wr * 64 + fr, col0 = u.pn * BM + wc * 32 + 4 * fq;
#pragma unroll
        for (int ai = 0; ai < 2; ++ai)
#pragma unroll
            for (int m = 0; m < 4; ++m) { float* rowp = out + (size_t)(row0 + ai * HALF + m * 16) * ldc + col0;
#pragma unroll
                for (int bj = 0; bj < 2; ++bj)
#pragma unroll
                    for (int n = 0; n < 2; ++n) *(f32x4*)(rowp + bj * HALF + n * 16) = acc[ai][bj][m][n] * scale; }
    }
};
struct EpiStore32Split {
    static constexpr bool RSLDS = false;
    bf16_t* out; int ldc; float scale; float* part;
    __device__ __forceinline__ void operator()(const f32x4 (&acc)[2][2][4][2], const Unit& u, int wr, int wc, int fr, int fq) const {
        const int row0 = wr * 64 + fr, col0 = wc * 32 + 8 * fq;
        if (u.part < 0) { bf16_t* base = out + (size_t)(u.pm * BM) * ldc + u.pn * BM;
#pragma unroll
            for (int ai = 0; ai < 2; ++ai)
#pragma unroll
                for (int m = 0; m < 4; ++m) { bf16_t* rowp = base + (size_t)(row0 + ai * HALF + m * 16) * ldc + col0;
#pragma unroll
                    for (int bj = 0; bj < 2; ++bj) { const f32x4 r0 = acc[ai][bj][m][0] * scale, r1 = acc[ai][bj][m][1] * scale;
                        u32x4 w; w.x = cvt_pk_bf16(r0[0], r0[1]); w.y = cvt_pk_bf16(r0[2], r0[3]); w.z = cvt_pk_bf16(r1[0], r1[1]); w.w = cvt_pk_bf16(r1[2], r1[3]); *(u32x4*)(rowp + bj * HALF) = w; } }
        } else { float* base = part + (size_t)u.part * (BM * BM);
#pragma unroll
            for (int ai = 0; ai < 2; ++ai)
#pragma unroll
                for (int m = 0; m < 4; ++m) { float* rowp = base + (size_t)(row0 + ai * HALF + m * 16) * BM + col0;
#pragma unroll
                    for (int bj = 0; bj < 2; ++bj)
#pragma unroll
                        for (int n = 0; n < 2; ++n) *(f32x4*)(rowp + bj * HALF + 4 * n) = acc[ai][bj][m][n] * scale; } }
    }
};
template <bool F8, bool I8IN> struct EpiGLU {
    static constexpr bool RSLDS = I8IN;
    void* out; int ldc; float s_in, s_out; const float* rowscale; const int* lists_base; const float* rsl; const LAS float* rs_lds;
    __device__ __forceinline__ const float* scale_src(const Unit& u) const { return u.rows ? rsl + (u.rows - lists_base) : rowscale + u.pm * BM; }
    __device__ __forceinline__ void operator()(const f32x4 (&acc)[2][2][4][2], const Unit& u, int wr, int wc, int fr, int fq) const {
        const int row0 = u.pm * BM + wr * 64 + fr, col0 = u.pn * HALF + wc * 32 + 8 * fq;
        float siv[2][4];
#pragma unroll
        for (int ai = 0; ai < 2; ++ai)
#pragma unroll
            for (int m = 0; m < 4; ++m) { siv[ai][m] = s_in;
                if constexpr (I8IN) siv[ai][m] = s_in * rs_lds[u.rsb + ai * HALF + wr * 64 + m * 16 + fr]; }
#pragma unroll
        for (int ai = 0; ai < 2; ++ai)
#pragma unroll
            for (int m = 0; m < 4; ++m) { const size_t off = (size_t)(row0 + ai * HALF + m * 16) * ldc + col0;
                const float si = siv[ai][m];
                f32x4 a00 = acc[ai][0][m][0], a01 = acc[ai][0][m][1], a10 = acc[ai][1][m][0], a11 = acc[ai][1][m][1];
                if constexpr (I8IN) {
                    const i32x4 b00 = __builtin_bit_cast(i32x4, a00), b01 = __builtin_bit_cast(i32x4, a01), b10 = __builtin_bit_cast(i32x4, a10), b11 = __builtin_bit_cast(i32x4, a11);
#pragma unroll
                    for (int j = 0; j < 4; ++j) { a00[j] = (float)b00[j]; a01[j] = (float)b01[j]; a10[j] = (float)b10[j]; a11[j] = (float)b11[j]; } }
                f32x4 y0, y1;
#pragma unroll
                for (int j = 0; j < 4; ++j) { y0[j] = silu_f(a00[j] * si) * (a01[j] * (si * s_out)); y1[j] = silu_f(a10[j] * si) * (a11[j] * (si * s_out)); }
                if constexpr (F8) { int w0 = 0, w1 = 0;
                    w0 = __builtin_amdgcn_cvt_pk_fp8_f32(y0[0], y0[1], w0, false); w0 = __builtin_amdgcn_cvt_pk_fp8_f32(y0[2], y0[3], w0, true);
                    w1 = __builtin_amdgcn_cvt_pk_fp8_f32(y1[0], y1[1], w1, false); w1 = __builtin_amdgcn_cvt_pk_fp8_f32(y1[2], y1[3], w1, true);
                    u32x2 w; w.x = (unsigned)w0; w.y = (unsigned)w1; *(u32x2*)((unsigned char*)out + off) = w; }
                else { u32x4 w; w.x = cvt_pk_bf16(y0[0], y0[1]); w.y = cvt_pk_bf16(y0[2], y0[3]); w.z = cvt_pk_bf16(y1[0], y1[1]); w.w = cvt_pk_bf16(y1[2], y1[3]);
                    *(u32x4*)((bf16_t*)out + off) = w; } }
    }
};
}

namespace att {
constexpr int KVB = 64;
constexpr int SHM_T = KVB * HD * 2;
constexpr int LDS_K = 0, LDS_V = 2 * SHM_T;
__device__ __forceinline__ int crow(int r, int hi) { return (r & 3) + 8 * (r >> 2) + 4 * hi; }
#define KSWZ(row, colB) ((row) * 256 + ((colB) ^ (((row) & 7) << 4)))
__device__ __forceinline__ int v_st(int k, int c) { const int kk = (k & ~0xC) | ((k & 4) << 1) | ((k & 8) >> 1); return ((kk >> 3) * 4 + (c >> 5)) * 512 + ((kk & 7) * 32 + (c & 31)) * 2; }
__device__ __forceinline__ int v_rd_base(int lane) { return ((lane & 3) << 3) | (((lane >> 2) & 3) << 6) | (((lane >> 4) & 1) << 5) | (((lane >> 5) & 1) << 8); }
constexpr int v_rd_off(int d0, int ks, int half) { return d0 * 512 + ks * 4096 + half * 2048; }
template <int OFF> __device__ __forceinline__ s16x4 tr_read(int vb) { s16x4 r; asm volatile("ds_read_b64_tr_b16 %0, %1 offset:%2" : "=&v"(r) : "v"(vb), "i"(OFF) : "memory"); return r; }
template <int D0> __device__ __forceinline__ void pv_one(f32x16& od, int vb, bf16x8 pa0, bf16x8 pa1, bf16x8 pa2, bf16x8 pa3) {
    const s16x4 l0 = tr_read<v_rd_off(D0, 0, 0)>(vb), h0 = tr_read<v_rd_off(D0, 0, 1)>(vb), l1 = tr_read<v_rd_off(D0, 1, 0)>(vb), h1 = tr_read<v_rd_off(D0, 1, 1)>(vb);
    const s16x4 l2 = tr_read<v_rd_off(D0, 2, 0)>(vb), h2 = tr_read<v_rd_off(D0, 2, 1)>(vb), l3 = tr_read<v_rd_off(D0, 3, 0)>(vb), h3 = tr_read<v_rd_off(D0, 3, 1)>(vb);
    asm volatile("s_waitcnt lgkmcnt(0)" ::: "memory"); __builtin_amdgcn_sched_barrier(0);
#define PK(L, H) (bf16x8){L[0], L[1], L[2], L[3], H[0], H[1], H[2], H[3]}
    od = __builtin_amdgcn_mfma_f32_32x32x16_bf16(pa0, PK(l0, h0), od, 0, 0, 0);
    od = __builtin_amdgcn_mfma_f32_32x32x16_bf16(pa1, PK(l1, h1), od, 0, 0, 0);
    od = __builtin_amdgcn_mfma_f32_32x32x16_bf16(pa2, PK(l2, h2), od, 0, 0, 0);
    od = __builtin_amdgcn_mfma_f32_32x32x16_bf16(pa3, PK(l3, h3), od, 0, 0, 0);
#undef PK
}
__device__ __forceinline__ void qkt(f32x16& p0, f32x16& p1, const LAS unsigned char* Ks, const bf16x8 (&qr)[8], int r32, int hi) {
    p0 = (f32x16){0.f, 0.f, 0.f, 0.f, 0.f, 0.f, 0.f, 0.f, 0.f, 0.f, 0.f, 0.f, 0.f, 0.f, 0.f, 0.f}; p1 = p0;
#pragma unroll
    for (int d0 = 0; d0 < 8; ++d0) { const int cb = (d0 * 16 + hi * 8) * 2;
        const bf16x8 b0 = *(const LAS bf16x8*)(Ks + KSWZ(r32, cb));
        const bf16x8 b1 = *(const LAS bf16x8*)(Ks + KSWZ(32 + r32, cb));
        p0 = __builtin_amdgcn_mfma_f32_32x32x16_bf16(b0, qr[d0], p0, 0, 0, 0);
        p1 = __builtin_amdgcn_mfma_f32_32x32x16_bf16(b1, qr[d0], p1, 0, 0, 0); }
}
__device__ __forceinline__ void sb_tile(f32x16& p0, f32x16& p1, float& C, int hi) {
    f32x2 a[16];
#pragma unroll
    for (int r = 0; r < 16; ++r) { a[r].x = frcp(1.0f + fexp2(p1[r])); a[r].y = frcp(1.0f + fexp2(p0[r])); }
    f32x2 s1v[4], s2v[4], s3v[4]; float tlo1[4], thi1[4], tlo0[4], thi0[4];
#pragma unroll
    for (int g = 0; g < 4; ++g) { s3v[g] = a[4 * g + 3]; s2v[g] = a[4 * g + 2] * s3v[g]; s1v[g] = a[4 * g + 1] * s2v[g]; const f32x2 s0 = a[4 * g] * s1v[g];
        const auto r1 = __builtin_amdgcn_permlane32_swap(__float_as_uint(s0.x), __float_as_uint(s0.x), false, false);
        const auto r0 = __builtin_amdgcn_permlane32_swap(__float_as_uint(s0.y), __float_as_uint(s0.y), false, false);
        tlo1[g] = __uint_as_float(r1[0]); thi1[g] = __uint_as_float(r1[1]); tlo0[g] = __uint_as_float(r0[0]); thi0[g] = __uint_as_float(r0[1]); }
    f32x2 off[4];
    { float c = C;
#pragma unroll
      for (int g = 3; g >= 0; --g) { off[g].x = hi ? c : c * thi1[g]; c *= tlo1[g] * thi1[g]; }
#pragma unroll
      for (int g = 3; g >= 0; --g) { off[g].y = hi ? c : c * thi0[g]; c *= tlo0[g] * thi0[g]; }
      C = c; }
#pragma unroll
    for (int g = 0; g < 4; ++g) {
        const f32x2 t3 = off[g], t2 = s3v[g] * off[g], t1 = s2v[g] * off[g], t0 = s1v[g] * off[g];
        const f32x2 w3 = t3 - a[4 * g + 3] * t3, w2 = t2 - a[4 * g + 2] * t2, w1 = t1 - a[4 * g + 1] * t1, w0 = t0 - a[4 * g] * t0;
        p1[4 * g + 3] = w3.x; p0[4 * g + 3] = w3.y; p1[4 * g + 2] = w2.x; p0[4 * g + 2] = w2.y; p1[4 * g + 1] = w1.x; p0[4 * g + 1] = w1.y; p1[4 * g] = w0.x; p0[4 * g] = w0.y;
    }
}
__device__ __forceinline__ void pack_p(const f32x16& p0, const f32x16& p1, bf16x8& pa0, bf16x8& pa1, bf16x8& pa2, bf16x8& pa3) {
#define PK4(P, BASE, OUT) do { unsigned a0 = cvt_pk_bf16(P[BASE + 0], P[BASE + 1]), a1 = cvt_pk_bf16(P[BASE + 2], P[BASE + 3]);   \
    unsigned b0 = cvt_pk_bf16(P[BASE + 4], P[BASE + 5]), b1 = cvt_pk_bf16(P[BASE + 6], P[BASE + 7]);                              \
    auto r0 = __builtin_amdgcn_permlane32_swap(a0, b0, false, false); auto r1 = __builtin_amdgcn_permlane32_swap(a1, b1, false, false); \
    u32x4 w = {r0[0], r1[0], r0[1], r1[1]}; OUT = *reinterpret_cast<bf16x8*>(&w); } while (0)
    PK4(p0, 0, pa0); PK4(p0, 8, pa1); PK4(p1, 0, pa2); PK4(p1, 8, pa3);
#undef PK4
}
__device__ __forceinline__ void unit(LAS unsigned char* lds, const bf16_t* __restrict__ Q, const bf16_t* __restrict__ Kg, const bf16_t* __restrict__ Vg, bf16_t* __restrict__ O, int b, int h, int qb) {
    const int tid = threadIdx.x, wid = __builtin_amdgcn_readfirstlane(tid >> 6), lane = tid & 63, r32 = lane & 31, hi = lane >> 5;
    const int q0 = qb * 256, NT = 4 * (qb + 1);
    const size_t tok0 = (size_t)b * SEQ;
    bf16x8 qr[8];
    { const bf16_t* Qw = Q + (tok0 + q0 + wid * 32 + r32) * 1024 + h * HD + hi * 8;
#pragma unroll
      for (int d0 = 0; d0 < 8; ++d0) qr[d0] = *(const bf16x8*)(Qw + d0 * 16); }
    f32x16 o[4];
#pragma unroll
    for (int d = 0; d < 4; ++d) o[d] = (f32x16){0.f, 0.f, 0.f, 0.f, 0.f, 0.f, 0.f, 0.f, 0.f, 0.f, 0.f, 0.f, 0.f, 0.f, 0.f, 0.f};
    float C = 1.0f;
    const int sr = tid >> 4, sc = (tid & 15) * 8, vst0 = v_st(sr, sc), vst1 = v_st(32 + sr, sc), kst0 = KSWZ(sr, sc * 2), kst1 = KSWZ(32 + sr, sc * 2);
    const bf16_t* Kh = Kg + tok0 * 1024 + h * HD + sc; const bf16_t* Vh = Vg + tok0 * 1024 + h * HD + sc;
    const int vbase = (int)(uintptr_t)(lds + LDS_V) + v_rd_base(lane);
    bf16x8 ka0, ka1, va0, va1, kb0, kb1, vb0, vb1;
#define SLOAD_A(j) do { const size_t k0_ = (size_t)(j) * KVB; ka0 = *(const bf16x8*)(Kh + (k0_ + sr) * 1024); ka1 = *(const bf16x8*)(Kh + (k0_ + 32 + sr) * 1024); \
        va0 = *(const bf16x8*)(Vh + (k0_ + sr) * 1024); va1 = *(const bf16x8*)(Vh + (k0_ + 32 + sr) * 1024); } while (0)
#define SLOAD_B(j) do { const size_t k0_ = (size_t)(j) * KVB; kb0 = *(const bf16x8*)(Kh + (k0_ + sr) * 1024); kb1 = *(const bf16x8*)(Kh + (k0_ + 32 + sr) * 1024); \
        vb0 = *(const bf16x8*)(Vh + (k0_ + sr) * 1024); vb1 = *(const bf16x8*)(Vh + (k0_ + 32 + sr) * 1024); } while (0)
#define SWRITE_A(bf) do { *(LAS bf16x8*)(lds + LDS_K + (bf) * SHM_T + kst0) = ka0; *(LAS bf16x8*)(lds + LDS_K + (bf) * SHM_T + kst1) = ka1; \
        *(LAS bf16x8*)(lds + LDS_V + (bf) * SHM_T + vst0) = va0; *(LAS bf16x8*)(lds + LDS_V + (bf) * SHM_T + vst1) = va1; } while (0)
#define SWRITE_B(bf) do { *(LAS bf16x8*)(lds + LDS_K + (bf) * SHM_T + kst0) = kb0; *(LAS bf16x8*)(lds + LDS_K + (bf) * SHM_T + kst1) = kb1; \
        *(LAS bf16x8*)(lds + LDS_V + (bf) * SHM_T + vst0) = vb0; *(LAS bf16x8*)(lds + LDS_V + (bf) * SHM_T + vst1) = vb1; } while (0)
    const int qmin = q0 + wid * 32, qrow = qmin + r32;
#define ATT_TILE(it_, bf_) do { const int j = NT - 1 - (it_), kmin = j * KVB; \
        if (kmin < qmin + 31) { f32x16 p0, p1; qkt(p0, p1, lds + LDS_K + (bf_) * SHM_T, qr, r32, hi); \
            if (kmin + 63 >= qmin) { _Pragma("unroll") for (int r = 0; r < 16; ++r) { const int key = kmin + crow(r, hi); p0[r] = key < qrow ? p0[r] : -__builtin_inff(); p1[r] = key + 32 < qrow ? p1[r] : -__builtin_inff(); } } \
            sb_tile(p0, p1, C, hi); bf16x8 pa0, pa1, pa2, pa3; pack_p(p0, p1, pa0, pa1, pa2, pa3); const int vb = vbase + (bf_) * SHM_T; \
            pv_one<0>(o[0], vb, pa0, pa1, pa2, pa3); pv_one<1>(o[1], vb, pa0, pa1, pa2, pa3); pv_one<2>(o[2], vb, pa0, pa1, pa2, pa3); pv_one<3>(o[3], vb, pa0, pa1, pa2, pa3); } } while (0)
    SLOAD_A(NT - 1); SWRITE_A(0); LDS_WAIT(); __builtin_amdgcn_s_barrier();
    SLOAD_A(NT - 2); SLOAD_B(NT - 3);
    for (int it = 0; it < NT; it += 2) {
        ATT_TILE(it, 0);
        SWRITE_A(1);
        LDS_WAIT(); __builtin_amdgcn_s_barrier();
        if (it + 3 < NT) SLOAD_A(NT - 4 - it);
        ATT_TILE(it + 1, 1);
        if (it + 2 < NT) SWRITE_B(0);
        LDS_WAIT(); __builtin_amdgcn_s_barrier();
        if (it + 4 < NT) SLOAD_B(NT - 5 - it);
    }
#undef SLOAD_A
#undef SLOAD_B
#undef SWRITE_A
#undef SWRITE_B
#undef ATT_TILE
    bf16_t* Ow = O + (tok0 + q0 + wid * 32) * 1024 + h * HD + r32;
#pragma unroll
    for (int r = 0; r < 16; ++r) { const int orow = crow(r, hi);
#pragma unroll
        for (int d0 = 0; d0 < 4; ++d0) Ow[(size_t)orow * 1024 + d0 * 32] = (bf16_t)(cvt_pk_bf16(o[d0][r], 0.f) & 0xffffu); }
}
}

constexpr int VT_PITCH = 272;
__device__ __forceinline__ void gate_unit(LAS unsigned char* lds, const bf16_t* __restrict__ VS, const bf16_t* __restrict__ U, const float* __restrict__ rsvs, const float* __restrict__ sgg,
                                          const bf16_t* __restrict__ Wt, const float* __restrict__ bs, bf16_t* __restrict__ Y, int n, int g) {
    const int tid = threadIdx.x, wid = __builtin_amdgcn_readfirstlane(tid >> 6), lane = tid & 63, r32 = lane & 31, hi = lane >> 5;
    const size_t tok0 = (size_t)n * 128;
    { const int s = tid >> 2, cb = (tid & 3) * 32; const f32x4 sq = *(const f32x4*)(rsvs + (tok0 + s) * 4); const float rs = 1.0f / sqrtf(((sq[0] + sq[1]) + (sq[2] + sq[3])) * (1.0f / SGW) + EPS); const bf16_t* src = VS + (tok0 + s) * 1024 + g * 128 + cb;
#pragma unroll
      for (int i = 0; i < 4; ++i) { const u32x4 w = *(const u32x4*)(src + 8 * i); const f32x4 g0 = *(const f32x4*)(sgg + g * 128 + cb + 8 * i), g1 = *(const f32x4*)(sgg + g * 128 + cb + 8 * i + 4);
          float v[8] = {bf_lo(w.x) * rs * g0[0], bf_hi(w.x) * rs * g0[1], bf_lo(w.y) * rs * g0[2], bf_hi(w.y) * rs * g0[3], bf_lo(w.z) * rs * g1[0], bf_hi(w.z) * rs * g1[1], bf_lo(w.w) * rs * g1[2], bf_hi(w.w) * rs * g1[3]};
#pragma unroll
          for (int e = 0; e < 8; ++e) *(LAS bf16_t*)(lds + (cb + 8 * i + e) * VT_PITCH + s * 2) = (bf16_t)(cvt_pk_bf16(v[e], 0.f) & 0xffffu); } }
    LDS_WAIT(); __builtin_amdgcn_s_barrier();
    const int tt = wid >> 1, ct0 = (wid & 1) * 2;
    f32x16 acc0 = (f32x16){0.f, 0.f, 0.f, 0.f, 0.f, 0.f, 0.f, 0.f, 0.f, 0.f, 0.f, 0.f, 0.f, 0.f, 0.f, 0.f}, acc1 = acc0;
    const bf16_t* Wrow = Wt + ((size_t)g * 128 + tt * 32 + r32) * 128 + hi * 8;
#pragma unroll
    for (int ks = 0; ks < 8; ++ks) {
        if (16 * ks <= 32 * tt + 31) {
            const bf16x8 a = *(const bf16x8*)(Wrow + ks * 16);
            const bf16x8 b0 = *(const LAS bf16x8*)(lds + (ct0 * 32 + r32) * VT_PITCH + (ks * 16 + hi * 8) * 2);
            const bf16x8 b1 = *(const LAS bf16x8*)(lds + (ct0 * 32 + 32 + r32) * VT_PITCH + (ks * 16 + hi * 8) * 2);
            acc0 = __builtin_amdgcn_mfma_f32_32x32x16_bf16(a, b0, acc0, 0, 0, 0);
            acc1 = __builtin_amdgcn_mfma_f32_32x32x16_bf16(a, b1, acc1, 0, 0, 0);
        }
    }
#pragma unroll
    for (int r = 0; r < 16; ++r) { const int t = tt * 32 + att::crow(r, hi); const float bb = bs[g * 128 + t];
        const size_t o0 = (tok0 + t) * 1024 + g * 128 + ct0 * 32 + r32;
        const float u0 = bf_lo((unsigned)U[o0]), u1 = bf_lo((unsigned)U[o0 + 32]);
        Y[o0] = (bf16_t)(cvt_pk_bf16(u0 * (acc0[r] + bb), 0.f) & 0xffffu); Y[o0 + 32] = (bf16_t)(cvt_pk_bf16(u1 * (acc1[r] + bb), 0.f) & 0xffffu); }
    LDS_WAIT(); __builtin_amdgcn_s_barrier();
}

template <int MAP  > __device__ __forceinline__ int rowmap(int c, int nsel) {
    if (MAP == 0) return c;
    if (MAP == 1) { const int c32 = c & 31; return (c & ~31) + 16 * ((c32 >> 2) & 1) + 4 * (c32 >> 3) + (c32 & 3); }
    const int pn = c >> 7, wc = (c >> 5) & 3, fq = (c >> 3) & 3, bj = (c >> 2) & 1, j = c & 3;
    return 256 * pn + 128 * bj + 32 * wc + 16 * nsel + 4 * fq + j;
}
__device__ __forceinline__ int rowmap_rt(int map, int c, int nsel) { return map == 0 ? rowmap<0>(c, nsel) : map == 1 ? rowmap<1>(c, nsel) : rowmap<2>(c, nsel); }
constexpr int CT_PITCH = 528;
constexpr int J_IN = 8 * 72, J_PJ = 4 * 16, J_WO = 8 * 16, J_F1 = 8 * 44, J_F2 = 22 * 16, J_M1 = 8 * 56, J_M2 = 28 * 16;
constexpr int J_LAYER = J_IN + 2 * J_PJ + J_WO, J_FFN = 2 * J_F1 + J_F2, J_EXP = 2 * J_M1 + J_M2, NITEMS = NL * J_LAYER + J_FFN + NE * J_EXP;
constexpr int N_ADA_ITEMS = NL * (NMOD * D) / 256;

struct Args { const float* in[22]; float* out; unsigned char* ws; int ph_lo, ph_hi; };
struct CvtJob { const float* W; bf16_t* dst; int K, N, map, nsel, k0, n0, f8; };

__device__ __forceinline__ void p0_decode(const Args& a, int it, CvtJob& j) {
    unsigned char* ws = a.ws; int r = it; const float* W; bf16_t* dst; int K, N, map, nsel = 0, f8 = 0;
    if (r < NL * J_LAYER) { const int l = r / J_LAYER; r -= l * J_LAYER;
        if (r < J_IN) { W = a.in[6] + (size_t)l * D * NIN; K = D; N = NIN; dst = (bf16_t*)(ws + WS_WIN + (size_t)l * NIN * D); map = 1; f8 = 2; }
        else if ((r -= J_IN) < J_PJ) { W = a.in[12] + (size_t)l * SBW * D; K = SBW; N = D; dst = (bf16_t*)(ws + WS_WPSB) + (size_t)l * D * SBW; map = 1; }
        else if ((r -= J_PJ) < J_PJ) { W = a.in[13] + (size_t)l * SGW * D; K = SGW; N = D; dst = (bf16_t*)(ws + WS_WPSG) + (size_t)l * D * SGW; map = 1; }
        else { r -= J_PJ; W = a.in[14] + (size_t)l * D * D; K = D; N = D; dst = (bf16_t*)(ws + WS_WOUT) + (size_t)l * D * D; map = 1; } }
    else if ((r -= NL * J_LAYER) < J_FFN) {
        if (r < J_F1) { W = a.in[15]; K = D; N = FD; dst = (bf16_t*)(ws + WS_WF13); map = 2; nsel = 0; f8 = 2; }
        else if ((r -= J_F1) < J_F1) { W = a.in[16]; K = D; N = FD; dst = (bf16_t*)(ws + WS_WF13); map = 2; nsel = 1; f8 = 2; }
        else { r -= J_F1; W = a.in[17]; K = FD; N = D; dst = (bf16_t*)(ws + WS_WF2); map = 1; f8 = FFN0_F8; } }
    else { r -= J_FFN; int e;
        if (r < NE * 2 * J_M1) { e = r / (2 * J_M1); r -= e * 2 * J_M1; } else { r -= NE * 2 * J_M1; e = r / J_M2; r -= e * J_M2; r += 2 * J_M1; }
        if (r < J_M1) { W = a.in[19] + (size_t)e * D * FE; K = D; N = FE; dst = (bf16_t*)(ws + WS_WM13 + (size_t)e * 2 * FE * D); map = 2; nsel = 0; f8 = 2; }
        else if ((r -= J_M1) < J_M1) { W = a.in[20] + (size_t)e * D * FE; K = D; N = FE; dst = (bf16_t*)(ws + WS_WM13 + (size_t)e * 2 * FE * D); map = 2; nsel = 1; f8 = 2; }
        else { r -= J_M1; W = a.in[21] + (size_t)e * FE * D; K = FE; N = D; dst = (bf16_t*)(ws + WS_WM2 + (size_t)e * D * FE); map = 1; f8 = 1; } }
    const int nblk = N >> 7, kb = r / nblk, nb = r - kb * nblk;
    j.W = W; j.dst = dst; j.K = K; j.N = N; j.map = map; j.nsel = nsel; j.k0 = kb * 256; j.n0 = nb * 128; j.f8 = f8;
}
__device__ __forceinline__ void p0_tile_load(const CvtJob& j, f32x4 (&v)[16], int tid) {
    const float* src = j.W + (size_t)(j.k0 + 16 * (tid >> 5)) * j.N + j.n0 + 4 * (tid & 31);
#pragma unroll
    for (int i = 0; i < 16; ++i) v[i] = __builtin_nontemporal_load((const f32x4*)(src + (size_t)i * j.N));
}
__device__ __forceinline__ unsigned pack_i8(float a, float b, float c, float d) {
    const float M = 12582912.0f;
    const unsigned ua = __float_as_uint(__builtin_amdgcn_fmed3f(a, -127.f, 127.f) + M), ub = __float_as_uint(__builtin_amdgcn_fmed3f(b, -127.f, 127.f) + M);
    const unsigned uc = __float_as_uint(__builtin_amdgcn_fmed3f(c, -127.f, 127.f) + M), ud = __float_as_uint(__builtin_amdgcn_fmed3f(d, -127.f, 127.f) + M);
    return (ua & 0xffu) | ((ub & 0xffu) << 8) | ((uc & 0xffu) << 16) | (ud << 24);
}
__device__ __forceinline__ void p0_tile_to_lds(const f32x4 (&v)[16], LAS unsigned char* lds, int tid, int f8) {
    const int kq = tid >> 5, nq = tid & 31;
    if (f8 == 2) {
#pragma unroll
        for (int jn = 0; jn < 4; ++jn) { unsigned w[4];
#pragma unroll
            for (int q = 0; q < 4; ++q) w[q] = pack_i8(v[4 * q][jn] * WI8_SCALE, v[4 * q + 1][jn] * WI8_SCALE, v[4 * q + 2][jn] * WI8_SCALE, v[4 * q + 3][jn] * WI8_SCALE);
            u32x4 o; o.x = w[0]; o.y = w[1]; o.z = w[2]; o.w = w[3];
            *(LAS u32x4*)(lds + (4 * nq + jn) * CT_PITCH + kq * 16) = o; }
    } else if (f8) {
#pragma unroll
        for (int jn = 0; jn < 4; ++jn) { int w[4];
#pragma unroll
            for (int q = 0; q < 4; ++q) { int x = 0; x = __builtin_amdgcn_cvt_pk_fp8_f32(v[4 * q][jn] * W8_SCALE, v[4 * q + 1][jn] * W8_SCALE, x, false); x = __builtin_amdgcn_cvt_pk_fp8_f32(v[4 * q + 2][jn] * W8_SCALE, v[4 * q + 3][jn] * W8_SCALE, x, true); w[q] = x; }
            u32x4 o; o.x = (unsigned)w[0]; o.y = (unsigned)w[1]; o.z = (unsigned)w[2]; o.w = (unsigned)w[3];
            *(LAS u32x4*)(lds + (4 * nq + jn) * CT_PITCH + kq * 16) = o; }
    } else {
#pragma unroll
        for (int jn = 0; jn < 4; ++jn) {
            u32x4 lo, hi;
            lo.x = cvt_pk_bf16(v[0][jn], v[1][jn]); lo.y = cvt_pk_bf16(v[2][jn], v[3][jn]); lo.z = cvt_pk_bf16(v[4][jn], v[5][jn]); lo.w = cvt_pk_bf16(v[6][jn], v[7][jn]);
            hi.x = cvt_pk_bf16(v[8][jn], v[9][jn]); hi.y = cvt_pk_bf16(v[10][jn], v[11][jn]); hi.z = cvt_pk_bf16(v[12][jn], v[13][jn]); hi.w = cvt_pk_bf16(v[14][jn], v[15][jn]);
            LAS unsigned char* p = lds + (4 * nq + jn) * CT_PITCH + kq * 32;
            *(LAS u32x4*)p = lo; *(LAS u32x4*)(p + 16) = hi;
        }
    }
}
__device__ __forceinline__ void p0_tile_store(const CvtJob& j, const LAS unsigned char* lds, int tid) {
    if (j.f8) {
        const int kc = tid & 15, nr = tid >> 4;
#pragma unroll
        for (int i2 = 0; i2 < 4; ++i2) { const int n = nr + 32 * i2; const u32x4 t = *(const LAS u32x4*)(lds + n * CT_PITCH + kc * 16);
            const int rho = rowmap_rt(j.map, j.n0 + n, j.nsel); __builtin_nontemporal_store(t, (u32x4*)((unsigned char*)j.dst + (size_t)rho * j.K + j.k0 + 16 * kc)); }
    } else {
        const int kc = tid & 31, nr = tid >> 5;
#pragma unroll
        for (int i2 = 0; i2 < 8; ++i2) { const int n = nr + 16 * i2; const u32x4 t = *(const LAS u32x4*)(lds + n * CT_PITCH + kc * 16);
            const int rho = rowmap_rt(j.map, j.n0 + n, j.nsel); __builtin_nontemporal_store(t, (u32x4*)(j.dst + (size_t)rho * j.K + j.k0 + 8 * kc)); }
    }
}
__device__ __forceinline__ void p0_adaln_item(const Args& a, int ai, const LAS float* cact, LAS float* red, int tid) {
    const int wave = tid >> 6, lane = tid & 63;
    const int l = ai / (N_ADA_ITEMS / NL), j0 = (ai % (N_ADA_ITEMS / NL)) * 256 + 4 * lane;
    const float* w = a.in[2] + (size_t)l * D * (NMOD * D) + (size_t)(wave * 256) * (NMOD * D) + j0;
    f32x4 acc0 = {0.f, 0.f, 0.f, 0.f}, acc1 = {0.f, 0.f, 0.f, 0.f};
    for (int k = 0; k < 256; k += 16) {
        f32x4 wv[16];
#pragma unroll
        for (int i = 0; i < 16; ++i) wv[i] = *(const f32x4*)(w + (size_t)(k + i) * (NMOD * D));
#pragma unroll
        for (int i = 0; i < 16; ++i) { const float c0 = cact[wave * 256 + k + i], c1 = cact[D + wave * 256 + k + i]; acc0 += c0 * wv[i]; acc1 += c1 * wv[i]; }
    }
    *(LAS f32x4*)(red + (wave * 2 + 0) * 256 + 4 * lane) = acc0; *(LAS f32x4*)(red + (wave * 2 + 1) * 256 + 4 * lane) = acc1;
    LDS_WAIT(); __syncthreads();
    { const int b = tid >> 8, c = tid & 255; float s = 0.f;
#pragma unroll
      for (int wv = 0; wv < 8; ++wv) s += red[(wv * 2 + b) * 256 + c];
      const int jj = (ai % (N_ADA_ITEMS / NL)) * 256 + c;
      ((float*)(a.ws + WS_MOD))[(size_t)l * NB * (NMOD * D) + (size_t)b * (NMOD * D) + jj] = s + a.in[3][(size_t)l * (NMOD * D) + jj]; }
    __syncthreads();
}

__device__ __forceinline__ bool convert_pool(const Args& args, LAS unsigned char* lds, volatile LAS int* nextw, unsigned* ctr, int first, int last, int maxn = 0x7fffffff) {
    const int tid = threadIdx.x;
    if (maxn <= 0) return true;
    int nclaimed = 1;
    if (tid == 0) nextw[0] = first + (int)__hip_atomic_fetch_add(ctr, 1u, RLX_AGENT);
    LDS_WAIT(); __syncthreads();
    int it = nextw[0];
    CvtJob cur, nxt; f32x4 v[16];
    if (it < last) { p0_decode(args, it, nxt); p0_tile_load(nxt, v, tid); }
    while (it < last) {
        cur = nxt;
        p0_tile_to_lds(v, lds, tid, cur.f8);
        if (tid == 0) nextw[1] = nclaimed < maxn ? first + (int)__hip_atomic_fetch_add(ctr, 1u, RLX_AGENT) : last;
        ++nclaimed;
        LDS_WAIT(); __syncthreads();
        it = nextw[1];
        if (it < last) { p0_decode(args, it, nxt); p0_tile_load(nxt, v, tid); }
        p0_tile_store(cur, lds, tid);
        LDS_WAIT(); __syncthreads();
    }
    return nclaimed > maxn;
}
constexpr int CV_MID = 4;
constexpr int NDEFER_DU = 768;
constexpr int NDEFER_W2 = NE * J_M2;
constexpr int MOEUP_CONV = 18;
constexpr int NDEFER0 = 3200, NDEFER1 = 3200, NDEFER = NDEFER0 + NDEFER1 + NDEFER_DU + NDEFER_W2;
static_assert(NDEFER <= NE * J_EXP, "only expert weights may be deferred");

template <bool ROUTER, bool I8OUT, bool XBF  >
__device__ __forceinline__ void norm_phase(const void* __restrict__ xin, const float* __restrict__ gain, const float* __restrict__ mod_shift, const float* __restrict__ mod_scale, bf16_t* __restrict__ hn,
                                           const float* __restrict__ wrouter, unsigned char* ws, LAS unsigned char* lds, int G, float* __restrict__ rs8 = nullptr) {
    const int tid = threadIdx.x, wave = __builtin_amdgcn_readfirstlane(tid >> 6), lane = tid & 63;
    const int gw = blockIdx.x * NWAVES + wave, NGW = G * NWAVES;
    LAS float* WR = (LAS float*)lds;
    if (ROUTER) {
        for (int i = tid; i < D * NE; i += NTHREADS) { const int d = i >> 3, e = i & 7; WR[e * D + d] = wrouter[i]; }
        LDS_WAIT(); __builtin_amdgcn_s_barrier();
    }
    const int b = gw & 1;
    f32x4 cA[8], cS[8];
#pragma unroll
    for (int i = 0; i < 8; ++i) { const int e = 4 * lane + 256 * i; const f32x4 g = *(const f32x4*)(gain + e), sc = *(const f32x4*)(mod_scale + (size_t)b * (NMOD * D) + e);
        cA[i] = g * (1.0f + sc); cS[i] = *(const f32x4*)(mod_shift + (size_t)b * (NMOD * D) + e); }
    for (int r = gw >> 1; r < SEQ; r += NGW >> 1) {
        const int t = b * SEQ + r;
        f32x4 v[8]; float ss = 0.f;
#pragma unroll
        for (int i = 0; i < 8; ++i) {
            if constexpr (XBF) { const u32x2 w = *(const u32x2*)((const bf16_t*)xin + (size_t)t * D + 4 * lane + 256 * i); v[i] = (f32x4){bf_lo(w.x), bf_hi(w.x), bf_lo(w.y), bf_hi(w.y)}; }
            else v[i] = *(const f32x4*)((const float*)xin + (size_t)t * D + 4 * lane + 256 * i);
            ss += (v[i][0] * v[i][0] + v[i][1] * v[i][1]) + (v[i][2] * v[i][2] + v[i][3] * v[i][3]); }
        const float rstd = 1.0f / sqrtf(wave_sum(ss) * (1.0f / D) + EPS);
        bf16_t* orow = hn + (size_t)t * D + 4 * lane;
#pragma unroll
        for (int i = 0; i < 8; ++i) v[i] = v[i] * rstd * cA[i] + cS[i];
        float rowsc = 0.f;
        if constexpr (I8OUT) {
            float am = 0.f;
#pragma unroll
            for (int i = 0; i < 8; ++i) am = fmaxf(fmaxf(am, fmaxf(fabsf(v[i][0]), fabsf(v[i][1]))), fmaxf(fabsf(v[i][2]), fabsf(v[i][3])));
#pragma unroll
            for (int o = 1; o < 64; o <<= 1) am = fmaxf(am, __shfl_xor(am, o));
            const float inv = am > 0.f ? 127.0f / am : 0.f;
            unsigned char* o8 = (unsigned char*)hn + (size_t)t * D + 4 * lane;
#pragma unroll
            for (int i = 0; i < 8; ++i) *(unsigned*)(o8 + 256 * i) = pack_i8(v[i][0] * inv, v[i][1] * inv, v[i][2] * inv, v[i][3] * inv);
            rowsc = am * (1.0f / 127.0f);
            if (lane == 0) rs8[t] = rowsc;
        } else {
#pragma unroll
            for (int i = 0; i < 8; ++i) { u32x2 w; w.x = cvt_pk_bf16(v[i][0], v[i][1]); w.y = cvt_pk_bf16(v[i][2], v[i][3]); *(u32x2*)(orow + 256 * i) = w; }
        }
        if (ROUTER) {
            asm volatile("" ::: "memory");
            float lg[NE];
#pragma unroll
            for (int e = 0; e < NE; ++e) { float s = 0.f;
#pragma unroll
                for (int i = 0; i < 8; ++i) { const f32x4 w = *(const LAS f32x4*)(WR + e * D + 4 * lane + 256 * i); s += (v[i][0] * w[0] + v[i][1] * w[1]) + (v[i][2] * w[2] + v[i][3] * w[3]); }
                lg[e] = wave_sum(s); }
            int e0 = 0; float v0 = lg[0];
#pragma unroll
            for (int e = 1; e < NE; ++e) if (lg[e] > v0) { v0 = lg[e]; e0 = e; }
            int e1 = -1; float v1 = -__builtin_inff();
#pragma unroll
            for (int e = 0; e < NE; ++e) if (e != e0 && lg[e] > v1) { v1 = lg[e]; e1 = e; }
            const float g0 = 1.0f / (1.0f + expf(v1 - v0)), g1 = 1.0f - g0;
            if (lane == 0) {
                unsigned* cnt = (unsigned*)(ws + WS_CTL) + CW_CNT;
                int* tok_e = (int*)(ws + WS_ROUTE); float* tok_g = (float*)(ws + WS_ROUTE + (size_t)T * 8); int* tok_pos = (int*)(ws + WS_ROUTE + (size_t)T * 16); int* lists = (int*)(ws + WS_ROUTE + (size_t)T * 24);
                const int p0 = (int)__hip_atomic_fetch_add(cnt + 64 * e0, 1u, RLX_AGENT), p1 = (int)__hip_atomic_fetch_add(cnt + 64 * e1, 1u, RLX_AGENT);
                lists[(size_t)e0 * T + p0] = t; lists[(size_t)e1 * T + p1] = t;
                float* rsl = (float*)(ws + WS_ROUTE + 512 * 1024); rsl[(size_t)e0 * T + p0] = rowsc; rsl[(size_t)e1 * T + p1] = rowsc;
                tok_e[2 * t] = e0; tok_e[2 * t + 1] = e1; tok_g[2 * t] = g0; tok_g[2 * t + 1] = g1; tok_pos[2 * t] = p0; tok_pos[2 * t + 1] = p1;
            }
        }
    }
}
__device__ __forceinline__ void post_phase(bf16_t* __restrict__ Q, bf16_t* __restrict__ Kb, const bf16_t* __restrict__ VS, float* __restrict__ rsvs, const float* __restrict__ gq, const float* __restrict__ gk, int G) {
    const int tid = threadIdx.x, wave = __builtin_amdgcn_readfirstlane(tid >> 6), lane = tid & 63;
    const int gw = blockIdx.x * NWAVES + wave, NGW = G * NWAVES;
    const int d0 = (lane & 15) * 8;
    float cq[8], ck[8];
#pragma unroll
    for (int j = 0; j < 8; ++j) { cq[j] = gq[d0 + j] * QSCALE; ck[j] = gk[d0 + j]; }
    for (int t = gw; t < T; t += NGW) {
#pragma unroll
        for (int which = 0; which < 2; ++which) {
            bf16_t* row = (which ? Kb : Q) + (size_t)t * 1024 + lane * 8;
#pragma unroll
            for (int i = 0; i < 2; ++i) { const u32x4 w = *(const u32x4*)(row + 512 * i);
                float v[8] = {bf_lo(w.x), bf_hi(w.x), bf_lo(w.y), bf_hi(w.y), bf_lo(w.z), bf_hi(w.z), bf_lo(w.w), bf_hi(w.w)};
                float ss = 0.f;
#pragma unroll
                for (int j = 0; j < 8; ++j) ss += v[j] * v[j];
                ss += __shfl_xor(ss, 1); ss += __shfl_xor(ss, 2); ss += __shfl_xor(ss, 4); ss += __shfl_xor(ss, 8);
                const float rstd = 1.0f / sqrtf(ss * (1.0f / HD) + EPS);
#pragma unroll
                for (int j = 0; j < 8; ++j) v[j] = v[j] * rstd * (which ? ck[j] : cq[j]);
                u32x4 o; o.x = cvt_pk_bf16(v[0], v[1]); o.y = cvt_pk_bf16(v[2], v[3]); o.z = cvt_pk_bf16(v[4], v[5]); o.w = cvt_pk_bf16(v[6], v[7]);
                *(u32x4*)(row + 512 * i) = o; }
        }
        { const bf16_t* row = VS + (size_t)t * 1024 + lane * 8; float ss = 0.f;
#pragma unroll
          for (int i = 0; i < 2; ++i) { const u32x4 w = *(const u32x4*)(row + 512 * i);
              const float v[8] = {bf_lo(w.x), bf_hi(w.x), bf_lo(w.y), bf_hi(w.y), bf_lo(w.z), bf_hi(w.z), bf_lo(w.w), bf_hi(w.w)};
#pragma unroll
              for (int j = 0; j < 8; ++j) ss += v[j] * v[j]; }
          ss = wave_sum(ss);
          if (lane == 0) rsvs[t] = 1.0f / sqrtf(ss * (1.0f / SGW) + EPS); }
    }
}
__device__ __forceinline__ void moe_tables(unsigned char* ws, volatile LAS int* tab) {
    if (threadIdx.x == 0) {
        unsigned* cnt = (unsigned*)(ws + WS_CTL) + CW_CNT; int rt = 0;
        for (int e = 0; e < NE; ++e) { const int c = (int)__hip_atomic_load(cnt + 64 * e, RLX_AGENT); tab[e] = rt; tab[16 + e] = c; const int n = (c + 255) >> 8; for (int i = 0; i < n; ++i) tab[32 + rt + i] = e; rt += n; }
        tab[8] = rt;
        const int G = (int)gridDim.x, nwg = rt * (D / 256), full = (nwg / G) * G, R = nwg - full;
        tab[9] = R == 0 ? 1 : R * 7 <= G ? 7 : R * 4 <= G ? 4 : R * 2 <= G ? 2 : 1; tab[10] = full;
    }
    LDS_WAIT(); __syncthreads();
}
__device__ __forceinline__ void combine_phase(const bf16_t* __restrict__ x1, const float* __restrict__ gate, const bf16_t* __restrict__ YM, const float* __restrict__ PART, float* __restrict__ out, unsigned char* ws, volatile LAS int* tab, int G) {
    const int tid = threadIdx.x, wave = __builtin_amdgcn_readfirstlane(tid >> 6), lane = tid & 63;
    const int nM = __builtin_amdgcn_readfirstlane(tab[8]), S = __builtin_amdgcn_readfirstlane(tab[9]), full = __builtin_amdgcn_readfirstlane(tab[10]), nwg = nM * (D / 256);
    for (int i = tid; i < nwg; i += NTHREADS) tab[128 + i] = -1;
    LDS_WAIT(); __syncthreads();
    if (S > 1) for (int j = tid; j < nwg - full; j += NTHREADS) { int pm, pn; pg8::tile_of(full + j, nM, D / 256, pm, pn); tab[128 + 8 * pm + pn] = j; }
    LDS_WAIT(); __syncthreads();
    const int gw = blockIdx.x * NWAVES + wave, NGW = G * NWAVES;
    const int* tok_e = (const int*)(ws + WS_ROUTE); const float* tok_g = (const float*)(ws + WS_ROUTE + (size_t)T * 8); const int* tok_pos = (const int*)(ws + WS_ROUTE + (size_t)T * 16);
    for (int t = gw; t < T; t += NGW) {
        const int e0 = tok_e[2 * t], e1 = tok_e[2 * t + 1]; const float g0 = tok_g[2 * t], g1 = tok_g[2 * t + 1];
        const size_t r0 = (size_t)tab[e0] * 256 + tok_pos[2 * t], r1 = (size_t)tab[e1] * 256 + tok_pos[2 * t + 1];
        const bf16_t* y0 = YM + r0 * D + 4 * lane; const bf16_t* y1 = YM + r1 * D + 4 * lane; const bf16_t* xr = x1 + (size_t)t * D + 4 * lane; const float* gv = gate + (size_t)(t >> 12) * (NMOD * D) + 4 * lane;
        float* orow = out + (size_t)t * D + 4 * lane;
#pragma unroll
        for (int i = 0; i < 8; ++i) { const u32x2 wa = *(const u32x2*)(y0 + 256 * i), wc = *(const u32x2*)(y1 + 256 * i), wx = *(const u32x2*)(xr + 256 * i);
            f32x4 a = {bf_lo(wa.x), bf_hi(wa.x), bf_lo(wa.y), bf_hi(wa.y)}, c = {bf_lo(wc.x), bf_hi(wc.x), bf_lo(wc.y), bf_hi(wc.y)}; const f32x4 x = {bf_lo(wx.x), bf_hi(wx.x), bf_lo(wx.y), bf_hi(wx.y)}, g = *(const f32x4*)(gv + 256 * i);
            const int j0 = __builtin_amdgcn_readfirstlane(tab[128 + 8 * (int)(r0 >> 8) + i]), j1 = __builtin_amdgcn_readfirstlane(tab[128 + 8 * (int)(r1 >> 8) + i]);
            if (j0 >= 0) { const float* p = PART + (size_t)j0 * (S - 1) * 65536 + (r0 & 255) * 256 + 4 * lane; for (int k = 0; k < S - 1; ++k) a += *(const f32x4*)(p + (size_t)k * 65536); }
            if (j1 >= 0) { const float* p = PART + (size_t)j1 * (S - 1) * 65536 + (r1 & 255) * 256 + 4 * lane; for (int k = 0; k < S - 1; ++k) c += *(const f32x4*)(p + (size_t)k * 65536); }
            __builtin_nontemporal_store((f32x4)(x + g * (g0 * a + g1 * c)), (f32x4*)(orow + 256 * i)); }
    }
}

#ifdef ONLY_PHASE
#ifndef ONLY_LAYER
#define ONLY_LAYER -1
#endif
#define IN(k) ((((k) - 1) % 10 + 1 == ONLY_PHASE || (k) == ONLY_PHASE) && (ONLY_LAYER < 0 || ((k) - 1) / 10 == ONLY_LAYER) && lo <= (k) && (k) < hi)
#else
#define IN(k) (lo <= (k) && (k) < hi)
#endif
#define SEAM(k) do { if ((k) + 1 < hi) xcd_barrier(bar); } while (0)
constexpr int NPHASE_FWD = 21;
template <int L>
__device__ __forceinline__ void layer_phases(const Args& args, LAS unsigned char* lds, volatile LAS int* moetab, const XcdBarrier& bar, const int lo, const int hi, const int G) {
    unsigned char* ws = args.ws;
        constexpr int l = L; constexpr int pb = 1 + 10 * l;
        const void* xin = l == 0 ? (const void*)args.in[0] : (const void*)(ws + WS_X2);
        const float* mod = (const float*)(ws + WS_MOD) + (size_t)l * NB * (NMOD * D);
        bf16_t* HN = (bf16_t*)(ws + WS_HN);
        bf16_t *Qb = (bf16_t*)(ws + WS_Q), *Kb = (bf16_t*)(ws + WS_K), *Vb = (bf16_t*)(ws + WS_V), *Ub = (bf16_t*)(ws + WS_U), *VSb = (bf16_t*)(ws + WS_VS), *GAb = (bf16_t*)(ws + WS_GA), *GBb = (bf16_t*)(ws + WS_GB);
        bf16_t *YSB = (bf16_t*)(ws + WS_YSB), *YSG = (bf16_t*)(ws + WS_YSG), *MRG = (bf16_t*)(ws + WS_MRG);
        bf16_t *X1 = (bf16_t*)(ws + WS_X1), *X2 = (bf16_t*)(ws + WS_X2); float* RSVS = (float*)(ws + WS_RSVS);

        if (IN(pb + 0)) { for (int rep_ = 0; rep_ < ((PROBE_REPEAT & 8) ? 2 : 1); ++rep_) norm_phase<false, true, l != 0>(xin, args.in[4] + (size_t)l * D, mod + 0 * D, mod + 1 * D, (bf16_t*)(ws + WS_HN8A + (size_t)l * T * D), nullptr, ws, lds, G, (float*)(ws + WS_RS8A) + (size_t)l * T); SEAM(pb + 0); }
        if (IN(pb + 1)) {
            pg8::DenseOrder S{(const char*)(ws + WS_HN8A + (size_t)l * T * D), (const char*)(ws + WS_WIN) + (size_t)l * NIN * D, T / 256, pg8::DYN_PN0, G, (int)blockIdx.x, (size_t)256 * D, (size_t)256 * D, GSH(0)};
            pg8::EpiInProj1 E{Qb, GAb, args.in[7] + (size_t)l * HD, args.in[8] + (size_t)l * HD, RSVS, (LAS float*)(lds + EPISCR_OFF), (const float*)(ws + WS_RS8A) + (size_t)l * T, (const LAS float*)(lds + RS_OFF)};
            pg8::gemm_phase<pg8::EpiInProj1, pg8::DenseOrder, false, 2>(lds, D, S, E);
            SEAM(pb + 1);
        }
        if (IN(pb + 3)) {
            for (int rep_ = 0; rep_ < ((PROBE_REPEAT & 4) ? 2 : 1); ++rep_) {
            if (G == 256) {
                const int rank = (int)blockIdx.x >> 4;
                const int ngu = (int)((0x5444332221110000ull >> (4 * rank)) & 15ull);
                const int pre = (int)(((rank < 8 ? 0x0302010000000000ull : 0x1b17130f0c090705ull) >> (8 * (rank & 7))) & 255ull);
                if (rank >= 8) convert_pool(args, lds, (volatile LAS int*)(lds + MISC_OFF + 64), (unsigned*)(ws + WS_CTL) + CW_P0CTR + 256 + 64 * l, l == 0 ? NITEMS - NDEFER_W2 - NDEFER0 - NDEFER1 : NITEMS - NDEFER_W2 - NDEFER1, l == 0 ? NITEMS - NDEFER_W2 - NDEFER1 : NITEMS - NDEFER_W2, 21);
                for (int k = 0; k < ngu; ++k) { const int gu = 16 * (pre + k) + ((int)blockIdx.x & 15); gate_unit(lds, VSb, Ub, RSVS, args.in[9] + (size_t)l * SGW, (const bf16_t*)(ws + WS_WSB) + (size_t)l * 8 * 128 * 128, args.in[11] + (size_t)l * 8 * 128, YSG, gu >> 3, gu & 7); }
            } else
            for (int gu = blockIdx.x; gu < (T / 128) * 8; gu += G) gate_unit(lds, VSb, Ub, RSVS, args.in[9] + (size_t)l * SGW, (const bf16_t*)(ws + WS_WSB) + (size_t)l * 8 * 128 * 128, args.in[11] + (size_t)l * 8 * 128, YSG, gu >> 3, gu & 7);
            for (int a = blockIdx.x; a < NB * NH * (SEQ / 256); a += G) { const int bh = a & 15, qb = 15 - (a >> 4); att::unit(lds, Qb, Kb, Vb, YSB, bh >> 3, bh & 7, qb); }
            __syncthreads(); }
            { unsigned* cvctr = (unsigned*)(ws + WS_CTL) + CW_P0CTR + 256 + 64 * l; const int cvfirst = l == 0 ? NITEMS - NDEFER_W2 - NDEFER0 - NDEFER1 : NITEMS - NDEFER_W2 - NDEFER1, cvlast = l == 0 ? NITEMS - NDEFER_W2 - NDEFER1 : NITEMS - NDEFER_W2;
              convert_pool(args, lds, (volatile LAS int*)(lds + MISC_OFF + 64), cvctr, cvfirst, cvlast, G == 256 ? (((int)blockIdx.x >> 4) < 8 ? 18 : 0) : CV_MID);
              { pg8::DynOrder S{(const char*)(ws + WS_HN8A + (size_t)l * T * D), (const char*)(ws + WS_WIN) + (size_t)l * NIN * D, (unsigned*)(ws + WS_CTL) + CW_DYN + 512 * l, (volatile LAS int*)(lds + MISC_OFF + 80), (int)(xb_xcc_id() & 7u), 0, (size_t)256 * D, (size_t)256 * D, pg8::DYN_PN0 + lo, 0x7fffffff, 0};
                pg8::EpiInProj E{Qb, GAb, (const float*)(ws + WS_RS8A) + (size_t)l * T, (const LAS float*)(lds + RS_OFF)};
                pg8::gemm_phase<pg8::EpiInProj, pg8::DynOrder, false, 2>(lds, D, S, E); }
              convert_pool(args, lds, (volatile LAS int*)(lds + MISC_OFF + 64), cvctr, cvfirst, cvlast); }
            SEAM(pb + 3);
        }
        if (IN(pb + 4)) {
            pg8::PairOrder S{(const char*)YSB, (const char*)(ws + WS_WPSB) + (size_t)l * D * SBW * 2, (const char*)YSG, (const char*)(ws + WS_WPSG) + (size_t)l * D * SGW * 2, T / 256, D / 256, G, (int)blockIdx.x, (size_t)256 * SBW * 2, (size_t)256 * SBW * 2, GSH(1)};
            pg8::EpiProjMerge E{GAb, GBb, (float*)(ws + WS_TMPF), MRG};
            pg8::gemm_phase<pg8::EpiProjMerge, pg8::PairOrder, false>(lds, 2 * SBW, S, E);
            SEAM(pb + 4);
        }
        if (IN(pb + 5)) {
            pg8::DenseOrder S{(const char*)MRG, (const char*)(ws + WS_WOUT) + (size_t)l * D * D * 2, T / 256, D / 256, G, (int)blockIdx.x, (size_t)256 * D * 2, (size_t)256 * D * 2, GSH(2)};
            pg8::EpiResid<l != 0> E{xin, mod + 2 * D, X1, 1.0f};
            pg8::gemm_phase<pg8::EpiResid<l != 0>, pg8::DenseOrder, false>(lds, 2 * D, S, E);
            SEAM(pb + 5);
        }
        if constexpr (l == 0) {
            if (IN(pb + 6)) { norm_phase<false, true, true>(X1, args.in[5] + (size_t)l * D, mod + 3 * D, mod + 4 * D, (bf16_t*)(ws + WS_HN8), nullptr, ws, lds, G, (float*)(ws + WS_RS8)); SEAM(pb + 6); }
            if (IN(pb + 7)) {
                pg8::DenseOrder S{(const char*)(ws + WS_HN8), (const char*)(ws + WS_WF13), T / 256, 2 * FD / 256, G, (int)blockIdx.x, (size_t)256 * D, (size_t)256 * D, GSH(3)};
                pg8::EpiGLU<false, true> E{(void*)(ws + WS_HID), FD, 1.0f / WI8_SCALE, 1.0f, (const float*)(ws + WS_RS8), nullptr, nullptr, (const LAS float*)(lds + RS_OFF)};
                pg8::gemm_phase<pg8::EpiGLU<false, true>, pg8::DenseOrder, false, 2>(lds, D, S, E);
                if (G != 256 || (int)blockIdx.x >= 128)
                    convert_pool(args, lds, (volatile LAS int*)(lds + MISC_OFF + 64), (unsigned*)(ws + WS_CTL) + CW_P0CTR + 192, NITEMS - NDEFER, NITEMS - NDEFER + NDEFER_DU, G == 256 ? 6 : 0x7fffffff);
                SEAM(pb + 7);
            }
            if (IN(pb + 8)) {
                pg8::DenseOrder S{(const char*)(ws + WS_HID), (const char*)(ws + WS_WF2), T / 256, D / 256, G, (int)blockIdx.x, (size_t)256 * FD * 2, (size_t)256 * FD * 2, GSH(4)};
                pg8::EpiResid<true> E{X1, mod + 5 * D, X2, 1.0f};
                pg8::gemm_phase<pg8::EpiResid<true>, pg8::DenseOrder, false>(lds, 2 * FD, S, E);
                SEAM(pb + 8);
            }
        } else {
            if (IN(pb + 6)) { norm_phase<true, true, true>(X1, args.in[5] + (size_t)l * D, mod + 3 * D, mod + 4 * D, (bf16_t*)(ws + WS_HN8), args.in[18], ws, lds, G, (float*)(ws + WS_RS8)); SEAM(pb + 6); }
            if (IN(pb + 7)) {
                moe_tables(ws, moetab);
                const int Gg = G == 256 ? G - MOEUP_CONV : G;
                if ((int)blockIdx.x >= Gg) convert_pool(args, lds, (volatile LAS int*)(lds + MISC_OFF + 64), (unsigned*)(ws + WS_CTL) + CW_P0CTR + 448, NITEMS - NDEFER_W2, NITEMS);
                pg8::MoeOrder S{(const char*)(ws + WS_HN8), (const char*)(ws + WS_WM13), (const int*)(ws + WS_ROUTE + (size_t)T * 24), moetab, 2 * FE / 256, Gg, (int)blockIdx.x, 1, (size_t)256 * D, (size_t)256 * D, (size_t)2 * FE * D, GSH(5)};
                pg8::EpiGLU<true, true> E{(void*)(ws + WS_HIDM), FE, 1.0f / WI8_SCALE, HID8_SCALE, (const float*)(ws + WS_RS8), (const int*)(ws + WS_ROUTE + (size_t)T * 24), (const float*)(ws + WS_ROUTE + 512 * 1024), (const LAS float*)(lds + RS_OFF)};
                if ((int)blockIdx.x < Gg) pg8::gemm_phase<pg8::EpiGLU<true, true>, pg8::MoeOrder, true, 2>(lds, D, S, E);
                convert_pool(args, lds, (volatile LAS int*)(lds + MISC_OFF + 64), (unsigned*)(ws + WS_CTL) + CW_P0CTR + 448, NITEMS - NDEFER_W2, NITEMS);
                SEAM(pb + 7);
            }
            if (IN(pb + 8)) {
                moe_tables(ws, moetab);
                pg8::MoeSplitOrder S{(const char*)(ws + WS_HIDM), (const char*)(ws + WS_WM2), moetab, D / 256, G, (int)blockIdx.x, FE / 128, (size_t)256 * FE, (size_t)256 * FE, (size_t)D * FE};
                pg8::EpiStore32Split E{(bf16_t*)(ws + WS_YM), D, 1.0f / (W8_SCALE * HID8_SCALE), (float*)(ws + WS_TMPF)};
                pg8::gemm_phase<pg8::EpiStore32Split, pg8::MoeSplitOrder, false, 1>(lds, FE, S, E);
                SEAM(pb + 8);
            }
            if (IN(pb + 9)) { moe_tables(ws, moetab); combine_phase(X1, mod + 5 * D, (const bf16_t*)(ws + WS_YM), (const float*)(ws + WS_TMPF), args.out, ws, moetab, G); }
        }

}
constexpr int NPHASE = 21;
__global__ void __launch_bounds__(NTHREADS, 2) fwd_kernel(Args args) {
    extern __shared__ __attribute__((aligned(16))) unsigned char lds_raw[];
    LAS unsigned char* lds = (LAS unsigned char*)lds_raw;
    volatile LAS unsigned* MISC = (volatile LAS unsigned*)(lds + MISC_OFF);
    volatile LAS int* moetab = (volatile LAS int*)(lds + MOETAB_OFF);
    const int tid = threadIdx.x, lane = tid & 63, wave = __builtin_amdgcn_readfirstlane(tid >> 6);
    const int G = gridDim.x;
    unsigned char* ws = args.ws;
    unsigned* ctl = (unsigned*)(ws + WS_CTL);
    for (int u = tid; u < (LDS_BYTES - LDSCTL_OFF) / 4; u += NTHREADS) ((LAS unsigned*)(lds + LDSCTL_OFF))[u] = 0u;
    __syncthreads();
    const int lo = args.ph_lo, hi = args.ph_hi;
    XcdBarrier bar; bar.bar = ctl + CW_BAR; bar.x = 0; bar.st = nullptr;
    if (hi - lo > 1) bar = xcd_barrier_post(ctl + CW_BAR, MISC + 8);

    if (IN(0)) {
        LAS float* cact = (LAS float*)(lds + 73728);
        LAS float* red = (LAS float*)(lds + 73728 + 16384);
        for (int i = tid; i < NB * D; i += NTHREADS) cact[i] = silu_f(args.in[1][i]);
        LDS_WAIT(); __syncthreads();
        for (int ai = blockIdx.x; ai < N_ADA_ITEMS; ai += G) p0_adaln_item(args, ai, cact, red, tid);
        for (int rep_ = 0; rep_ < ((PROBE_REPEAT & 1) ? 2 : 1); ++rep_) {
            convert_pool(args, lds, (volatile LAS int*)(MISC + 16), ctl + CW_P0CTR + 64 * rep_, 0, NITEMS - NDEFER);
        }
        { bf16_t* wsb = (bf16_t*)(ws + WS_WSB); const float* w_s = args.in[10];
          for (int i = blockIdx.x * NTHREADS + tid; i < NL * 8 * 128 * 128; i += G * NTHREADS) { const int s = i & 127, t = (i >> 7) & 127; wsb[i] = (bf16_t)(cvt_pk_bf16(s <= t ? w_s[i] : 0.f, 0.f) & 0xffffu); } }
        SEAM(0);
    }

    layer_phases<0>(args, lds, moetab, bar, lo, hi, G);
    layer_phases<1>(args, lds, moetab, bar, lo, hi, G);
#undef IN
#undef SEAM
}

extern "C" void kernel_launch(void* const* d_in, const int* in_sizes, int n_in, void* d_out, int out_size, void* d_ws, size_t ws_size, hipStream_t stream) {
    static int grid = 0;
    if (grid == 0) {
        if (n_in != 22 || out_size != T * D || ws_size < WS_END) { fprintf(stderr, "kernel_launch: unexpected shapes (n_in %d out %d ws %zu, need ws >= %zu); nothing launched\n", n_in, out_size, ws_size, (size_t)WS_END); grid = -1; return; }
        int dev = 0, cus = 0, per_cu = 0;
        if (hipGetDevice(&dev) != hipSuccess || hipDeviceGetAttribute(&cus, hipDeviceAttributeMultiprocessorCount, dev) != hipSuccess) { grid = -1; return; }
        if (hipFuncSetAttribute((const void*)fwd_kernel, hipFuncAttributeMaxDynamicSharedMemorySize, LDS_BYTES) != hipSuccess) { fprintf(stderr, "kernel_launch: hipFuncSetAttribute failed\n"); grid = -1; return; }
        if (hipOccupancyMaxActiveBlocksPerMultiprocessor(&per_cu, (const void*)fwd_kernel, NTHREADS, LDS_BYTES) != hipSuccess || per_cu < 1) { fprintf(stderr, "kernel_launch: occupancy query says %d blocks per CU\n", per_cu); }
        (void)hipGetLastError();
        grid = cus;
    }
    if (grid < 0) return;
    (void)hipMemsetAsync((char*)d_ws + WS_CTL, 0, CTL_ZERO_BYTES, stream);
    Args a{};
    for (int i = 0; i < 22; ++i) a.in[i] = (const float*)d_in[i];
    a.out = (float*)d_out; a.ws = (unsigned char*)d_ws;
#if MK_PER_PHASE
    for (int p = 0; p < NPHASE; ++p) { if (p == 10 || p == 3 || p == 13) continue; a.ph_lo = p; a.ph_hi = p + 1; hipLaunchKernelGGL(fwd_kernel, dim3(grid), dim3(NTHREADS), LDS_BYTES, stream, a); }
#else
    a.ph_lo = 0; a.ph_hi = NPHASE;
    hipLaunchKernelGGL(fwd_kernel, dim3(grid), dim3(NTHREADS), LDS_BYTES, stream, a);
#endif
    const hipError_t le = hipPeekAtLastError();
    if (le != hipSuccess) fprintf(stderr, "kernel_launch: launch failed: %s\n", hipGetErrorName(le));
}
```

```cpp
#include <hip/hip_runtime.h>
#include <cstdio>
#include <cstdint>

#ifndef MK_PER_PHASE
#define MK_PER_PHASE 0
#endif
#ifndef FFN0_F8
#define FFN0_F8 1
#endif
#ifndef PROBE_GSITE
#define PROBE_GSITE 0
#endif
#define GSH(s) ((PROBE_GSITE >> (s)) & 1)
#ifndef PROBE_EPI
#define PROBE_EPI 0
#endif
#ifndef PROBE_REPEAT
#define PROBE_REPEAT 0
#endif

#define LAS __attribute__((address_space(3)))
#define GAS __attribute__((address_space(1)))
typedef unsigned short bf16_t;
typedef short bf16x8 __attribute__((ext_vector_type(8)));
typedef short s16x4 __attribute__((ext_vector_type(4)));
typedef float f32x2 __attribute__((ext_vector_type(2)));
typedef float f32x4 __attribute__((ext_vector_type(4)));
typedef float f32x16 __attribute__((ext_vector_type(16)));
typedef unsigned u32x2 __attribute__((ext_vector_type(2)));
typedef unsigned u32x4 __attribute__((ext_vector_type(4)));

constexpr int NB = 2, SEQ = 4096, T = NB * SEQ, D = 2048, NH = 8, HD = 128, SBW = 1024, SGW = 1024;
constexpr int NIN = 3 * SBW + 2 * SGW + 2 * D;
constexpr int FD = 5632, FE = 7168, NE = 8, NL = 2, NMOD = 6;
constexpr float EPS = 1e-6f;
constexpr float LOG2E = 1.4426950408889634f;
constexpr float QSCALE = 0.08838834764831845f * LOG2E;

constexpr size_t MiB = (size_t)1 << 20;
constexpr size_t WS_CTL = 0, CTL_ZERO_BYTES = 1 * MiB;
constexpr size_t WS_MOD = 1 * MiB;
constexpr size_t WS_RSVS = 2 * MiB;
constexpr size_t WS_ROUTE = 3 * MiB;
constexpr size_t WS_WSB = 4 * MiB;
constexpr size_t WS_WIN = 8 * MiB;
constexpr size_t WS_WPSB = 80 * MiB;
constexpr size_t WS_WPSG = 88 * MiB;
constexpr size_t WS_WOUT = 96 * MiB;
constexpr size_t WS_WF13 = 112 * MiB;
constexpr size_t WS_WF2 = 156 * MiB;
constexpr size_t WS_WM13 = 178 * MiB;
constexpr size_t WS_WM2 = 626 * MiB;
constexpr size_t WS_HN = 850 * MiB;
constexpr size_t WS_Q = 882 * MiB, WS_K = 898 * MiB, WS_V = 914 * MiB, WS_U = 930 * MiB, WS_VS = 946 * MiB;
constexpr size_t WS_GA = 962 * MiB, WS_GB = 994 * MiB;
constexpr size_t WS_YSB = 1026 * MiB, WS_YSG = 1042 * MiB;
constexpr size_t WS_MRG = 1058 * MiB;
constexpr size_t WS_TMPF = 1090 * MiB;
constexpr size_t WS_X1 = 1154 * MiB;
constexpr size_t WS_X2 = 1218 * MiB;
constexpr size_t WS_HID = 1282 * MiB;
constexpr size_t WS_HIDM = 1370 * MiB;
constexpr size_t WS_YM = 1622 * MiB;
constexpr size_t WS_HN8 = 1766 * MiB;
constexpr size_t WS_END = 1782 * MiB;
static_assert(WS_K - WS_Q == 16 * MiB && WS_V - WS_K == 16 * MiB && WS_U - WS_V == 16 * MiB && WS_VS - WS_U == 16 * MiB && WS_GB - WS_GA == 32 * MiB, "EpiInProj strides");
constexpr float WI8_SCALE = 1024.0f;
constexpr size_t WS_RS8 = 2 * MiB + 512 * 1024;
constexpr size_t WS_RS8A = 2 * MiB + 768 * 1024;
constexpr size_t WS_HN8A = WS_HN;
constexpr float W8_SCALE = 256.0f, HID8_SCALE = 8.0f;
constexpr int MOE_ROWS = 2 * T + NE * 256;
constexpr int MAXRT = MOE_ROWS / 256;
constexpr int CW_TMO = 0, CW_P0CTR = 64, CW_BAR = 4096, CW_CNT = 8192, CW_DYN = 12288;

constexpr int RING_BYTES = 131072;
constexpr int LDSCTL_OFF = RING_BYTES, MISC_OFF = LDSCTL_OFF + 320, MOETAB_OFF = LDSCTL_OFF + 1024, EPISCR_OFF = LDSCTL_OFF + 4096;
constexpr int RS_OFF = EPISCR_OFF + 8192;
constexpr int LDS_BYTES = 147456;
static_assert(RS_OFF + 2048 <= LDS_BYTES, "LDS map");
constexpr int NWAVES = 8, NTHREADS = NWAVES * 64;

typedef __bf16 bf16x2_t __attribute__((ext_vector_type(2)));
__device__ __forceinline__ unsigned cvt_pk_bf16(float lo, float hi) { const f32x2 v = {lo, hi}; const bf16x2_t b = __builtin_convertvector(v, bf16x2_t); return __builtin_bit_cast(unsigned, b); }
__device__ __forceinline__ float bf_lo(unsigned w) { return __uint_as_float(w << 16); }
__device__ __forceinline__ float bf_hi(unsigned w) { return __uint_as_float(w & 0xffff0000u); }
__device__ __forceinline__ float fexp2(float x) { return __builtin_amdgcn_exp2f(x); }
__device__ __forceinline__ float frcp(float x) { return __builtin_amdgcn_rcpf(x); }
__device__ __forceinline__ float sigmoid_f(float x) { return frcp(1.0f + fexp2(-LOG2E * x)); }
__device__ __forceinline__ float silu_f(float x) { return x * sigmoid_f(x); }
__device__ __forceinline__ float gelu_tanh_f(float x) { const float t = x * (1.0f + 0.044715f * x * x); return x * frcp(1.0f + fexp2(-2.3022082f * t)); }
__device__ __forceinline__ float wave_sum(float v) {
#pragma unroll
    for (int o = 1; o < 64; o <<= 1) v += __shfl_xor(v, o);
    return v;
}
#define LDS_WAIT() asm volatile("s_waitcnt lgkmcnt(0)" ::: "memory")
#define VM_WAIT() asm volatile("s_waitcnt vmcnt(0)" ::: "memory")
#define RLX_AGENT __ATOMIC_RELAXED, __HIP_MEMORY_SCOPE_AGENT

#define XB_TMO      128
#define XB_XCNT(j)  (256  + 64 * (j))
#define XB_XSUB(j)  (1280 + 64 * (j))
#define XB_XGEN(j)  (2304 + 64 * (j))
#define XB_TOP      3328
#define XB_TOPGEN   3392
#define XCD_BAR_WORDS 3456
#define XB_SPIN_CAP (1u << 18)
__device__ __forceinline__ unsigned xb_ld(unsigned* p)              { return __hip_atomic_load(p, __ATOMIC_RELAXED, __HIP_MEMORY_SCOPE_AGENT); }
__device__ __forceinline__ unsigned xb_add(unsigned* p, unsigned v) { return __hip_atomic_fetch_add(p, v, __ATOMIC_RELAXED, __HIP_MEMORY_SCOPE_AGENT); }
__device__ __forceinline__ unsigned xb_xcc_id() { return (unsigned)__builtin_amdgcn_s_getreg((3 << 11) | 20) & 0xFu; }
#define XB_SPIN(cond, bar) do { unsigned _sp = 0; while (cond) { __builtin_amdgcn_s_sleep(1); \
    if ((++_sp & 255u) == 0u) { if (xb_ld(&(bar)[XB_TMO])) break; if (_sp > XB_SPIN_CAP) { atomicAdd(&(bar)[XB_TMO], 1u); break; } } } } while (0)
struct XcdBarrier { unsigned* bar; unsigned x; volatile LAS unsigned* st; };
__device__ __forceinline__ XcdBarrier xcd_barrier_post(unsigned* bar, volatile LAS unsigned* st) {
    XcdBarrier b; b.bar = bar; b.x = xb_xcc_id(); b.st = st;
    if (threadIdx.x == 0) (void)xb_add(&bar[XB_XCNT(b.x)], 1u);
    return b;
}
__device__ __forceinline__ void xcd_barrier_complete(unsigned* bar, unsigned x, unsigned& nloc, unsigned& nx) {
    const unsigned G = gridDim.x * gridDim.y * gridDim.z;
    unsigned sum, cnt, mine, sp = 0u;
    for (;;) {
        sum = 0u; cnt = 0u; mine = 0u;
#pragma unroll
        for (unsigned j = 0; j < 16; ++j) { const unsigned c = xb_ld(&bar[XB_XCNT(j)]); sum += c; cnt += (c > 0u) ? 1u : 0u; mine = (j == x) ? c : mine; }
        if (sum == G) break;
        __builtin_amdgcn_s_sleep(1);
        if ((++sp & 255u) == 0u) { if (xb_ld(&bar[XB_TMO])) break; if (sp > XB_SPIN_CAP) { atomicAdd(&bar[XB_TMO], 1u); break; } }
    }
    nloc = mine > 0u ? mine : 1u; nx = cnt > 0u ? cnt : 1u;
}
__device__ __forceinline__ void xcd_barrier(const XcdBarrier& b) {
    asm volatile("s_waitcnt vmcnt(0)" ::: "memory");
    __syncthreads();
    if (threadIdx.x == 0) {
        unsigned* bar = b.bar;
        __builtin_amdgcn_s_waitcnt(0);
        unsigned nloc = b.st[0], nx = b.st[1];
        if (nloc == 0u) { xcd_barrier_complete(bar, b.x, nloc, nx); b.st[0] = nloc; b.st[1] = nx; }
        const unsigned old = xb_add(&bar[XB_XSUB(b.x)], 1u);
        const unsigned gen = old / nloc;
        if (old + 1u == (gen + 1u) * nloc) {
            __builtin_amdgcn_fence(__ATOMIC_RELEASE, "agent");
            asm volatile("s_waitcnt vmcnt(0)" ::: "memory");
            const unsigned og = xb_add(&bar[XB_TOP], 1u);
            const unsigned tg = og / nx;
            if (og + 1u == (tg + 1u) * nx) xb_add(&bar[XB_TOPGEN], 1u);
            else XB_SPIN(xb_ld(&bar[XB_TOPGEN]) == tg, bar);
            __builtin_amdgcn_fence(__ATOMIC_ACQUIRE, "agent");
            xb_add(&bar[XB_XGEN(b.x)], 1u);
            asm volatile("s_waitcnt vmcnt(0)" ::: "memory");
        } else {
            XB_SPIN(xb_ld(&bar[XB_XGEN(b.x)]) == gen, bar);
            __builtin_amdgcn_fence(__ATOMIC_ACQUIRE, "agent");
            asm volatile("s_waitcnt vmcnt(0)" ::: "memory");
        }
    }
    __syncthreads();
}

namespace pg8 {
constexpr int BM = 256, BK = 64, HALF = 128, HTB = HALF * BK * 2, STAGE_BYTES = 8 * HTB, NXCD = 8, WGM = 8;
__host__ __device__ __forceinline__ int lds_byte(int r, int c) { const int st = (r >> 4) * 2 + (c >> 5), rr = r & 15, cc = c & 31, ob = rr * 64 + cc * 2; return st * 1024 + (ob ^ (((ob >> 9) & 1) << 5)); }
__host__ __device__ __forceinline__ void stage_rc(int b, int& R, int& C) { const int st = b / 1024, sb = b % 1024, swz = sb ^ (((sb >> 9) & 1) << 5); R = (st >> 1) * 16 + swz / 64; C = (st & 1) * 32 + (swz % 64) / 2; }

struct Unit { int pm, pn, aux, nvalid; const char* A; const char* B; const int* rows; int nt, part, rsb; };

__device__ __forceinline__ void tile_of(int L, int nM, int nN, int& pm, int& pn) {
    const int nwg = nM * nN;
    int wgid = L; { const int q = nwg / NXCD, r = nwg % NXCD, xcd = wgid % NXCD, off = wgid / NXCD; wgid = (xcd < r ? xcd * (q + 1) : r * (q + 1) + (xcd - r) * q) + off; }
    const int nig = WGM * nN, gid = wgid / nig, fm = gid * WGM, gsz = (nM - fm) < WGM ? (nM - fm) : WGM;
    pm = fm + ((wgid % nig) % gsz); pn = (wgid % nig) / gsz;
}
__device__ __forceinline__ bool tile_order(int i, int G, int c, int nM, int nN, int& pm, int& pn) {
    const int nwg = nM * nN; const long L = (long)i * G + c; if (L >= nwg) return false;
    int wgid = (int)L; { const int q = nwg / NXCD, r = nwg % NXCD, xcd = wgid % NXCD, off = wgid / NXCD; wgid = (xcd < r ? xcd * (q + 1) : r * (q + 1) + (xcd - r) * q) + off; }
    const int nig = WGM * nN, gid = wgid / nig, fm = gid * WGM, gsz = (nM - fm) < WGM ? (nM - fm) : WGM;
    pm = fm + ((wgid % nig) % gsz); pn = (wgid % nig) / gsz; return true;
}

typedef int i32x4 __attribute__((ext_vector_type(4)));
typedef int i32x8 __attribute__((ext_vector_type(8)));
__device__ __forceinline__ i32x8 cat8(bf16x8 a, bf16x8 b) { const i32x4 x = __builtin_bit_cast(i32x4, a), y = __builtin_bit_cast(i32x4, b); return __builtin_shufflevector(x, y, 0, 1, 2, 3, 4, 5, 6, 7); }
__device__ __forceinline__ void glds16s(const char* sbase, unsigned voff, unsigned lds_dst) { unsigned keep;
    asm volatile("s_mov_b32 %0, m0\n\ts_mov_b32 m0, %3\n\ts_nop 0\n\tglobal_load_lds_dwordx4 %1, %2\n\ts_mov_b32 m0, %0" : "=&s"(keep) : "v"(voff), "s"(sbase), "s"(lds_dst) : "memory"); }
__device__ __forceinline__ void glds4s(const char* sbase, unsigned voff, unsigned lds_dst) { unsigned keep;
    asm volatile("s_mov_b32 %0, m0\n\ts_mov_b32 m0, %3\n\ts_nop 0\n\tglobal_load_lds_dword %1, %2\n\ts_mov_b32 m0, %0" : "=&s"(keep) : "v"(voff), "s"(sbase), "s"(lds_dst) : "memory"); }
__device__ __forceinline__ void mfma8(f32x4& acc, const i32x8& a, const i32x8& b) { asm volatile("v_mfma_f32_16x16x128_f8f6f4 %0, %1, %2, %0" : "+v"(acc) : "v"(a), "v"(b)); }
template <bool GATHER>
__device__ __forceinline__ void mk_voff(const Unit& u, int RB, int R0, int R1, int C0, int C1, unsigned& v00, unsigned& v01, unsigned& v10, unsigned& v11) {
    int r00 = R0, r01 = R1, r10 = 128 + R0, r11 = 128 + R1;
    if (GATHER) {
        const int a = u.rows[r00], b = u.rows[r01], c = u.rows[r10], d = u.rows[r11];
        r00 = r00 < u.nvalid ? a : 0; r01 = r01 < u.nvalid ? b : 0; r10 = r10 < u.nvalid ? c : 0; r11 = r11 < u.nvalid ? d : 0;
    }
    v00 = (unsigned)(r00 * RB + 2 * C0); v01 = (unsigned)(r01 * RB + 2 * C1); v10 = (unsigned)(r10 * RB + 2 * C0); v11 = (unsigned)(r11 * RB + 2 * C1);
}

template <class Epi, class Sched, bool GATHER, int MODE = 0  >
__device__ __forceinline__ void gemm_phase(LAS unsigned char* lds, const int K, Sched& S, const Epi& E) {
    const int tid = threadIdx.x, wid = __builtin_amdgcn_readfirstlane(tid >> 6), lane = tid & 63, wr = wid >> 2, wc = wid & 3, fr = lane & 15, fq = lane >> 4;
    constexpr bool FP8 = MODE == 1;
    const int nt = K / 128;
    int R0, C0, R1, C1; stage_rc(tid * 16, R0, C0); stage_rc(tid * 16 + 8192, R1, C1);
    unsigned voffB[2]; voffB[0] = (unsigned)(R0 * K + 2 * C0); voffB[1] = (unsigned)(R1 * K + 2 * C1);
    const size_t kstep = (size_t)(BK * 2);
    const size_t hstepB = (size_t)HALF * K;
    const unsigned ldsw = (unsigned)wid * 1024u;
    const unsigned ldsbase = (unsigned)__builtin_amdgcn_readfirstlane((int)(unsigned)(uintptr_t)lds) + ldsw;
    const int aoff = lds_byte(wr * 64 + fr, fq * 8), boff = lds_byte(wc * 32 + fr, fq * 8);
#define PG8_SA(b, h) (((b) * 2 + (h)) * HTB)
#define PG8_SB(b, h) ((4 + (b) * 2 + (h)) * HTB)
#define PG8_STAGE2(bufoff, gbase, o0, o1) do { glds16s((gbase), (o0), ldsbase + (unsigned)(bufoff)); glds16s((gbase), (o1), ldsbase + (unsigned)(bufoff) + 8192u); } while (0)
#define PG8_STAGE_B(bufoff, gbase) PG8_STAGE2(bufoff, gbase, voffB[0], voffB[1])
#define PG8_LDA(dst, b, h) do { if constexpr (FP8) { _Pragma("unroll") for (int m = 0; m < 4; ++m) dst##8[m] = cat8(*(const LAS bf16x8*)(lds + PG8_SA(b, h) + aoff + m * 2048), *(const LAS bf16x8*)(lds + PG8_SA(b, h) + aoff + m * 2048 + 1024)); } \
        else { _Pragma("unroll") for (int m = 0; m < 4; ++m) _Pragma("unroll") for (int k = 0; k < 2; ++k) dst[m][k] = *(const LAS bf16x8*)(lds + PG8_SA(b, h) + aoff + m * 2048 + k * 1024); } } while (0)
#define PG8_LDB(dst, b, h) do { if constexpr (FP8) { _Pragma("unroll") for (int n = 0; n < 2; ++n) dst##8[n] = cat8(*(const LAS bf16x8*)(lds + PG8_SB(b, h) + boff + n * 2048), *(const LAS bf16x8*)(lds + PG8_SB(b, h) + boff + n * 2048 + 1024)); } \
        else { _Pragma("unroll") for (int n = 0; n < 2; ++n) _Pragma("unroll") for (int k = 0; k < 2; ++k) dst[n][k] = *(const LAS bf16x8*)(lds + PG8_SB(b, h) + boff + n * 2048 + k * 1024); } } while (0)
#define PG8_MMA(ai, bj, At, Bt) do { __builtin_amdgcn_s_setprio(1); _Pragma("unroll") for (int m = 0; m < 4; ++m) _Pragma("unroll") for (int n = 0; n < 2; ++n) { \
        if constexpr (FP8) { mfma8(acc[ai][bj][m][n], Bt##8[n], At##8[m]); } \
        else if constexpr (MODE == 2) { _Pragma("unroll") for (int k = 0; k < 2; ++k) acc[ai][bj][m][n] = __builtin_bit_cast(f32x4, __builtin_amdgcn_mfma_i32_16x16x64_i8(__builtin_bit_cast(i32x4, Bt[n][k]), __builtin_bit_cast(i32x4, At[m][k]), __builtin_bit_cast(i32x4, acc[ai][bj][m][n]), 0, 0, 0)); } \
        else { _Pragma("unroll") for (int k = 0; k < 2; ++k) acc[ai][bj][m][n] = __builtin_amdgcn_mfma_f32_16x16x32_bf16(Bt[n][k], At[m][k], acc[ai][bj][m][n], 0, 0, 0); } } \
        __builtin_amdgcn_s_setprio(0); } while (0)
#define PG8_WAIT_V(n) asm volatile("s_waitcnt vmcnt(" #n ")" ::: "memory")
#define PG8_WAIT_L(n) asm volatile("s_waitcnt lgkmcnt(" #n ")" ::: "memory")
#define PG8_BAR __builtin_amdgcn_s_barrier()
#define PG8_SCHED __builtin_amdgcn_sched_barrier(0)
    Unit cur, nxt; int ui = 0;
    if (!S.next(0, cur)) return;
    f32x4 acc[2][2][4][2];
#pragma unroll
    for (int a = 0; a < 2; ++a)
#pragma unroll
        for (int b = 0; b < 2; ++b)
#pragma unroll
            for (int m = 0; m < 4; ++m)
#pragma unroll
                for (int n = 0; n < 2; ++n) acc[a][b][m][n] = (f32x4){0.f, 0.f, 0.f, 0.f};
    bf16x8 At[4][2], B0[2][2], B1[2][2]; i32x8 At8[4], B08[2], B18[2];
    const char* cA = cur.A; const char* cB = cur.B;
    unsigned c00, c01, c10, c11;
    mk_voff<GATHER>(cur, K, R0, R1, C0, C1, c00, c01, c10, c11);
#define PG8_RS(un, par) do { if constexpr (Epi::RSLDS) { un.rsb = (par) * 256; if (wid < 4) glds4s((const char*)E.scale_src(un), (unsigned)(tid * 4), ldsbase - ldsw + (unsigned)RS_OFF + (unsigned)(par) * 1024u + (unsigned)wid * 256u); } } while (0)
    PG8_RS(cur, 0);
    PG8_STAGE_B(PG8_SB(0, 0), cB); PG8_STAGE_B(PG8_SB(0, 1), cB + hstepB); PG8_STAGE2(PG8_SA(0, 0), cA, c00, c01); PG8_STAGE2(PG8_SA(0, 1), cA, c10, c11);
    if (wr == 1) PG8_BAR;
    PG8_WAIT_V(2); PG8_BAR;
    PG8_STAGE_B(PG8_SB(1, 0), cB + kstep); PG8_STAGE2(PG8_SA(1, 0), cA + kstep, c00, c01); PG8_STAGE_B(PG8_SB(1, 1), cB + hstepB + kstep);
    PG8_WAIT_V(6); PG8_BAR;
    for (;;) {
        const bool has_next = S.next(ui + 1, nxt);
        const char* nA = has_next ? nxt.A : cA; const char* nB = has_next ? nxt.B : cB;
        unsigned n00 = c00, n01 = c01, n10 = c10, n11 = c11;
        if (GATHER) { if (has_next) mk_voff<GATHER>(nxt, K, R0, R1, C0, C1, n00, n01, n10, n11); }
        int ntc = nt; if constexpr (Sched::VARK) ntc = cur.nt;
        for (int t = 0; t < ntc; t += 2) {
            const bool last = (t == ntc - 2);
            const char* a1 = cA + (size_t)(t + 1) * kstep;
            const char* a2 = last ? nA : cA + (size_t)(t + 2) * kstep; const char* b2 = last ? nB : cB + (size_t)(t + 2) * kstep;
            const char* a3 = a2 + kstep; const char* b3 = b2 + kstep;
            unsigned s00 = c00, s01 = c01, s10 = c10, s11 = c11;
            if (GATHER) { s00 = last ? n00 : c00; s01 = last ? n01 : c01; s10 = last ? n10 : c10; s11 = last ? n11 : c11; }
            PG8_LDB(B0, 0, 0); PG8_LDB(B1, 0, 1); PG8_SCHED; PG8_LDA(At, 0, 0); PG8_STAGE2(PG8_SA(1, 1), a1, c10, c11);
            PG8_WAIT_V(8); PG8_WAIT_L(0); PG8_BAR; PG8_MMA(0, 0, At, B0); PG8_MMA(0, 1, At, B1); PG8_BAR; PG8_SCHED;
            PG8_LDA(At, 0, 1); PG8_STAGE_B(PG8_SB(0, 0), b2); PG8_STAGE_B(PG8_SB(0, 1), b2 + hstepB); PG8_STAGE2(PG8_SA(0, 0), a2, s00, s01);
            PG8_WAIT_V(8); PG8_WAIT_L(0); PG8_BAR; PG8_MMA(1, 0, At, B0); PG8_MMA(1, 1, At, B1); PG8_BAR; PG8_SCHED;
            PG8_LDB(B0, 1, 0); PG8_LDB(B1, 1, 1); PG8_SCHED; PG8_LDA(At, 1, 0); PG8_STAGE2(PG8_SA(0, 1), a2, s10, s11);
            PG8_WAIT_V(8); PG8_WAIT_L(0); PG8_BAR; PG8_MMA(0, 0, At, B0); PG8_MMA(0, 1, At, B1); PG8_BAR; PG8_SCHED;
            PG8_LDA(At, 1, 1); PG8_STAGE_B(PG8_SB(1, 0), b3); PG8_STAGE_B(PG8_SB(1, 1), b3 + hstepB); PG8_STAGE2(PG8_SA(1, 0), a3, s00, s01);
            PG8_WAIT_V(8); PG8_WAIT_L(0); PG8_BAR; PG8_MMA(1, 0, At, B0); PG8_MMA(1, 1, At, B1); PG8_BAR; PG8_SCHED;
        }
        if (wr == 0) PG8_BAR;
        if constexpr (FP8) asm volatile("s_nop 15\n\ts_nop 7" ::: "memory");
        E(acc, cur, wr, wc, fr, fq);
#if PROBE_EPI
        asm volatile("" ::: "memory"); E(acc, cur, wr, wc, fr, fq);
#endif
        if (!has_next) break;
#pragma unroll
        for (int a = 0; a < 2; ++a)
#pragma unroll
            for (int b = 0; b < 2; ++b)
#pragma unroll
                for (int m = 0; m < 4; ++m)
#pragma unroll
                    for (int n = 0; n < 2; ++n) acc[a][b][m][n] = (f32x4){0.f, 0.f, 0.f, 0.f};
        cur = nxt; cA = nA; cB = nB; ++ui;
        PG8_RS(cur, ui & 1);
        if (GATHER) { c00 = n00; c01 = n01; c10 = n10; c11 = n11; }
        if (wr == 1) PG8_BAR;
    }
    PG8_WAIT_V(0);
    PG8_BAR;
#undef PG8_RS
#undef PG8_SA
#undef PG8_SB
#undef PG8_STAGE2
#undef PG8_STAGE_B
#undef PG8_LDA
#undef PG8_LDB
#undef PG8_MMA
#undef PG8_WAIT_V
#undef PG8_WAIT_L
#undef PG8_BAR
#undef PG8_SCHED
}

struct DenseOrder {
    static constexpr bool VARK = false;
    const char* A; const char* B; int nM, nN, G, c; size_t tstepA, tstepB; int rsh;
    __device__ __forceinline__ bool next(int i, Unit& u) const {
        int pm, pn; if (!tile_order(i >> rsh, G, c, nM, nN, pm, pn)) return false;
        u.pm = pm; u.pn = pn; u.aux = 0; u.nvalid = 256; u.A = A + (size_t)pm * tstepA; u.B = B + (size_t)pn * tstepB; u.rows = nullptr; return true;
    }
};
struct PairOrder {
    static constexpr bool VARK = false;
    const char* A0; const char* B0; const char* A1; const char* B1; int nM, nN, G, c; size_t tstepA, tstepB; int rsh;
    __device__ __forceinline__ bool next(int i, Unit& u) const {
        int pm, pn; if (!tile_order(i >> (1 + rsh), G, c, nM, nN, pm, pn)) return false;
        const int w = i & 1;
        u.pm = pm; u.pn = pn; u.aux = w; u.nvalid = 256; u.A = (w ? A1 : A0) + (size_t)pm * tstepA; u.B = (w ? B1 : B0) + (size_t)pn * tstepB; u.rows = nullptr; return true;
    }
};
constexpr int DYN_PN0 = 24, DYN_NPN = 12, DYN_LIST = 4 * DYN_NPN;
struct DynOrder {
    static constexpr bool VARK = false;
    const char* A; const char* B; unsigned* cnt; volatile LAS int* word; int x, k; size_t tstepA, tstepB; int pn0; int budget, done;
    __device__ __forceinline__ bool next(int, Unit& u) {
        if (budget <= 0) return false;
        --budget;
        if (threadIdx.x < 64) {
            int v = -1;
            while (k < 8) { const int list = (x + k) & 7; int got = 0;
                if (threadIdx.x == 0) got = (int)__hip_atomic_fetch_add(cnt + 64 * list, 1u, RLX_AGENT);
                got = __builtin_amdgcn_readfirstlane(got);
                if (got < DYN_LIST) { v = list * 64 + got; break; }
                ++k; }
            if (threadIdx.x == 0) word[0] = v;
            asm volatile("s_waitcnt lgkmcnt(0)" ::: "memory");
        }
        asm volatile("" ::: "memory"); __builtin_amdgcn_s_barrier(); asm volatile("" ::: "memory");
        const int v = __builtin_amdgcn_readfirstlane(word[0]);
        if (v < 0) { done = 1; return false; }
        const int list = v >> 6, got = v & 63, pm = 4 * list + (got & 3), pn = pn0 + (got >> 2);
        u.pm = pm; u.pn = pn; u.aux = 0; u.nvalid = 256; u.A = A + (size_t)pm * tstepA; u.B = B + (size_t)pn * tstepB; u.rows = nullptr; return true;
    }
};
struct MoeSplitOrder {
    static constexpr bool VARK = true;
    const char* A; const char* B; const volatile LAS int* tab; int nN, G, c, NT; size_t tstepA, tstepB, estepB;
    __device__ __forceinline__ bool next(int i, Unit& u) const {
        const int nM = __builtin_amdgcn_readfirstlane(tab[8]), S = __builtin_amdgcn_readfirstlane(tab[9]), full = __builtin_amdgcn_readfirstlane(tab[10]);
        const int nwg = nM * nN, L = i * G + c;
        int unit = L, kp = 0, part = -1, ntu = NT;
        if (L >= full && S > 1) { const int j = L - full, tl = j / S; if (tl >= nwg - full) return false; unit = full + tl; kp = j - tl * S; ntu = NT / S; part = kp ? tl * (S - 1) + kp - 1 : -1; }
        else if (L >= nwg) return false;
        int pm, pn; tile_of(unit, nM, nN, pm, pn);
        const int e = __builtin_amdgcn_readfirstlane(tab[32 + pm]);
        u.pm = pm; u.pn = pn; u.aux = e; u.nvalid = 256; u.rows = nullptr; u.nt = ntu; u.part = part;
        u.A = A + (size_t)pm * tstepA + (size_t)(kp * ntu) * 128; u.B = B + (size_t)e * estepB + (size_t)pn * tstepB + (size_t)(kp * ntu) * 128;
        return true;
    }
};
struct MoeOrder {
    static constexpr bool VARK = false;
    const char* A; const char* B; const int* lists; const volatile LAS int* tab; int nN, G, c, gather; size_t tstepA, tstepB, estepB; int rsh;
    __device__ __forceinline__ bool next(int i, Unit& u) const {
        const int nM = __builtin_amdgcn_readfirstlane(tab[8]);
        int pm, pn; if (!tile_order(i >> rsh, G, c, nM, nN, pm, pn)) return false;
        const int e = __builtin_amdgcn_readfirstlane(tab[32 + pm]);
        const int lt = pm - __builtin_amdgcn_readfirstlane(tab[e]);
        const int cnt = __builtin_amdgcn_readfirstlane(tab[16 + e]);
        u.pm = pm; u.pn = pn; u.aux = e; u.B = B + (size_t)e * estepB + (size_t)pn * tstepB;
        if (gather) { u.A = A; u.rows = lists + (size_t)e * T + lt * 256; u.nvalid = cnt - lt * 256; }
        else { u.A = A + (size_t)pm * tstepA; u.rows = nullptr; u.nvalid = 256; }
        return true;
    }
};

template <bool I8> __device__ __forceinline__ f32x4 cvt_acc(const f32x4& a, float sc) {
    if constexpr (I8) { const i32x4 b = __builtin_bit_cast(i32x4, a); f32x4 r; r[0] = (float)b[0] * sc; r[1] = (float)b[1] * sc; r[2] = (float)b[2] * sc; r[3] = (float)b[3] * sc; return r; }
    else return a;
}
struct EpiInProj {
    static constexpr bool RSLDS = true;
    bf16_t *Q, *GA; const float* rowscale; const LAS float* rs_lds;
    __device__ __forceinline__ const float* scale_src(const Unit& u) const { return rowscale + u.pm * BM; }
    __device__ __forceinline__ void operator()(const f32x4 (&acc)[2][2][4][2], const Unit& u, int wr, int wc, int fr, int fq) const {
        const int q = u.pn - 20; bf16_t* base = GA + (size_t)(q >> 3) * (size_t)(16u << 20); const int colt = (q & 7) * 256;
        const int row0 = u.pm * BM + wr * 64 + fr, col0 = colt + wc * 32 + 8 * fq;
        float rsv[2][4];
#pragma unroll
        for (int ai = 0; ai < 2; ++ai)
#pragma unroll
            for (int m = 0; m < 4; ++m) rsv[ai][m] = rs_lds[u.rsb + wr * 64 + fr + ai * HALF + m * 16] * (1.0f / WI8_SCALE);
#pragma unroll
        for (int ai = 0; ai < 2; ++ai)
#pragma unroll
            for (int m = 0; m < 4; ++m) { bf16_t* rowp = base + (size_t)(row0 + ai * HALF + m * 16) * 2048 + col0; const float rs = rsv[ai][m];
#pragma unroll
                for (int bj = 0; bj < 2; ++bj) { f32x4 v0 = cvt_acc<true>(acc[ai][bj][m][0], rs), v1 = cvt_acc<true>(acc[ai][bj][m][1], rs);
#pragma unroll
                    for (int j = 0; j < 4; ++j) { v0[j] = sigmoid_f(v0[j]); v1[j] = sigmoid_f(v1[j]); }
                    u32x4 w; w.x = cvt_pk_bf16(v0[0], v0[1]); w.y = cvt_pk_bf16(v0[2], v0[3]); w.z = cvt_pk_bf16(v1[0], v1[1]); w.w = cvt_pk_bf16(v1[2], v1[3]);
                    *(u32x4*)(rowp + bj * HALF) = w; } }
    }
};
struct EpiInProj1 {
    static constexpr bool RSLDS = true;
    bf16_t *Q, *GA; const float *gq, *gk; float* SSQ; LAS float* scr; const float* rowscale; const LAS float* rs_lds;
    __device__ __forceinline__ const float* scale_src(const Unit& u) const { return rowscale + u.pm * BM; }
    __device__ __forceinline__ void operator()(const f32x4 (&acc)[2][2][4][2], const Unit& u, int wr, int wc, int fr, int fq) const {
        const int pn = u.pn;
        const int row0 = u.pm * BM + wr * 64 + fr;
        float rsv[2][4];
#pragma unroll
        for (int ai = 0; ai < 2; ++ai)
#pragma unroll
            for (int m = 0; m < 4; ++m) rsv[ai][m] = rs_lds[u.rsb + wr * 64 + fr + ai * HALF + m * 16] * (1.0f / WI8_SCALE);
#define ACCF(ai, bj, m, n) cvt_acc<true>(acc[ai][bj][m][n], rsv[ai][m])
        if (pn < 8) {
            const bool isq = pn < 4; const float* gv = (isq ? gq : gk) + wc * 32 + 8 * fq; const float mul = isq ? QSCALE : 1.0f;
            const f32x4 g0 = *(const f32x4*)gv, g1 = *(const f32x4*)(gv + 4);
            bf16_t* base = Q + (size_t)(pn >> 2) * (size_t)(8u << 20); const int col0 = (pn & 3) * 256 + wc * 32 + 8 * fq;
#pragma unroll
            for (int ai = 0; ai < 2; ++ai)
#pragma unroll
                for (int m = 0; m < 4; ++m)
#pragma unroll
                    for (int bj = 0; bj < 2; ++bj) { const f32x4 v0 = ACCF(ai, bj, m, 0), v1 = ACCF(ai, bj, m, 1);
                        float ss = (v0[0] * v0[0] + v0[1] * v0[1]) + (v0[2] * v0[2] + v0[3] * v0[3]) + (v1[0] * v1[0] + v1[1] * v1[1]) + (v1[2] * v1[2] + v1[3] * v1[3]);
                        ss += __shfl_xor(ss, 16); ss += __shfl_xor(ss, 32);
                        if (fq == 0) scr[(ai * HALF + wr * 64 + m * 16 + fr) * 8 + bj * 4 + wc] = ss; }
            asm volatile("s_waitcnt lgkmcnt(0)" ::: "memory"); __builtin_amdgcn_s_barrier(); asm volatile("" ::: "memory");
#pragma unroll
            for (int ai = 0; ai < 2; ++ai)
#pragma unroll
                for (int m = 0; m < 4; ++m) { bf16_t* rowp = base + (size_t)(row0 + ai * HALF + m * 16) * 1024 + col0;
#pragma unroll
                    for (int bj = 0; bj < 2; ++bj) { const f32x4 pp = *(const LAS f32x4*)(scr + (ai * HALF + wr * 64 + m * 16 + fr) * 8 + bj * 4);
                        const float rs = mul / sqrtf(((pp[0] + pp[1]) + (pp[2] + pp[3])) * (1.0f / HD) + EPS);
                        const f32x4 v0 = ACCF(ai, bj, m, 0) * rs * g0, v1 = ACCF(ai, bj, m, 1) * rs * g1;
                        u32x4 w; w.x = cvt_pk_bf16(v0[0], v0[1]); w.y = cvt_pk_bf16(v0[2], v0[3]); w.z = cvt_pk_bf16(v1[0], v1[1]); w.w = cvt_pk_bf16(v1[2], v1[3]);
                        *(u32x4*)(rowp + bj * HALF) = w; } }
        } else if (pn < 12) {
            bf16_t* base = Q + (size_t)2 * (size_t)(8u << 20); const int col0 = (pn & 3) * 256 + wc * 32 + 8 * fq;
#pragma unroll
            for (int ai = 0; ai < 2; ++ai)
#pragma unroll
                for (int m = 0; m < 4; ++m) { bf16_t* rowp = base + (size_t)(row0 + ai * HALF + m * 16) * 1024 + col0;
#pragma unroll
                    for (int bj = 0; bj < 2; ++bj) { const f32x4 v0 = ACCF(ai, bj, m, 0), v1 = ACCF(ai, bj, m, 1);
                        u32x4 w; w.x = cvt_pk_bf16(v0[0], v0[1]); w.y = cvt_pk_bf16(v0[2], v0[3]); w.z = cvt_pk_bf16(v1[0], v1[1]); w.w = cvt_pk_bf16(v1[2], v1[3]);
                        *(u32x4*)(rowp + bj * HALF) = w; } }
        } else if (pn < 20) {
            const bool isvs = pn >= 16; bf16_t* base = Q + (size_t)(pn >> 2) * (size_t)(8u << 20); const int col0 = (pn & 3) * 256 + wc * 32 + 8 * fq;
#pragma unroll
            for (int ai = 0; ai < 2; ++ai)
#pragma unroll
                for (int m = 0; m < 4; ++m) { bf16_t* rowp = base + (size_t)(row0 + ai * HALF + m * 16) * 1024 + col0; float ss = 0.f;
#pragma unroll
                    for (int bj = 0; bj < 2; ++bj) { f32x4 v0 = ACCF(ai, bj, m, 0), v1 = ACCF(ai, bj, m, 1);
#pragma unroll
                        for (int j = 0; j < 4; ++j) { v0[j] = gelu_tanh_f(v0[j]); v1[j] = gelu_tanh_f(v1[j]); }
                        ss += (v0[0] * v0[0] + v0[1] * v0[1]) + (v0[2] * v0[2] + v0[3] * v0[3]) + (v1[0] * v1[0] + v1[1] * v1[1]) + (v1[2] * v1[2] + v1[3] * v1[3]);
                        u32x4 w; w.x = cvt_pk_bf16(v0[0], v0[1]); w.y = cvt_pk_bf16(v0[2], v0[3]); w.z = cvt_pk_bf16(v1[0], v1[1]); w.w = cvt_pk_bf16(v1[2], v1[3]);
                        *(u32x4*)(rowp + bj * HALF) = w; }
                    if (isvs) { ss += __shfl_xor(ss, 16); ss += __shfl_xor(ss, 32); if (fq == 0) scr[(ai * HALF + wr * 64 + m * 16 + fr) * 8 + wc] = ss; } }
            if (isvs) {
                asm volatile("s_waitcnt lgkmcnt(0)" ::: "memory"); __builtin_amdgcn_s_barrier(); asm volatile("" ::: "memory");
                const int t = threadIdx.x;
                if (t < 256) { const f32x4 pp = *(const LAS f32x4*)(scr + t * 8); SSQ[(size_t)(u.pm * BM + t) * 4 + (pn - 16)] = (pp[0] + pp[1]) + (pp[2] + pp[3]); }
            }
        } else {
            const int q = pn - 20; bf16_t* base = GA; const int col0 = q * 256 + wc * 32 + 8 * fq;
#pragma unroll
            for (int ai = 0; ai < 2; ++ai)
#pragma unroll
                for (int m = 0; m < 4; ++m) { bf16_t* rowp = base + (size_t)(row0 + ai * HALF + m * 16) * 2048 + col0;
#pragma unroll
                    for (int bj = 0; bj < 2; ++bj) { f32x4 v0 = ACCF(ai, bj, m, 0), v1 = ACCF(ai, bj, m, 1);
#pragma unroll
                        for (int j = 0; j < 4; ++j) { v0[j] = sigmoid_f(v0[j]); v1[j] = sigmoid_f(v1[j]); }
                        u32x4 w; w.x = cvt_pk_bf16(v0[0], v0[1]); w.y = cvt_pk_bf16(v0[2], v0[3]); w.z = cvt_pk_bf16(v1[0], v1[1]); w.w = cvt_pk_bf16(v1[2], v1[3]);
                        *(u32x4*)(rowp + bj * HALF) = w; } }
        }
#undef ACCF
    }
};
struct EpiProjMerge {
    static constexpr bool RSLDS = false;
    const bf16_t *GA, *GB; float* TMP; bf16_t* MRG;
    __device__ __forceinline__ void operator()(const f32x4 (&acc)[2][2][4][2], const Unit& u, int wr, int wc, int fr, int fq) const {
        const int row0 = u.pm * BM + wr * 64 + fr, col0 = u.pn * BM + wc * 32 + 8 * fq;
        if (u.aux == 0) {
#pragma unroll
            for (int ai = 0; ai < 2; ++ai) {
              u32x4 gg[4][2];
#pragma unroll
              for (int m = 0; m < 4; ++m)
#pragma unroll
                for (int bj = 0; bj < 2; ++bj) gg[m][bj] = *(const u32x4*)(GA + (size_t)(row0 + ai * HALF + m * 16) * D + col0 + bj * HALF);
#pragma unroll
                for (int m = 0; m < 4; ++m) { const size_t off = (size_t)(row0 + ai * HALF + m * 16) * D + col0;
#pragma unroll
                    for (int bj = 0; bj < 2; ++bj) { const u32x4 g = gg[m][bj]; const f32x4 v0 = acc[ai][bj][m][0], v1 = acc[ai][bj][m][1];
                        f32x4 o0, o1; o0[0] = bf_lo(g.x) * v0[0]; o0[1] = bf_hi(g.x) * v0[1]; o0[2] = bf_lo(g.y) * v0[2]; o0[3] = bf_hi(g.y) * v0[3];
                        o1[0] = bf_lo(g.z) * v1[0]; o1[1] = bf_hi(g.z) * v1[1]; o1[2] = bf_lo(g.w) * v1[2]; o1[3] = bf_hi(g.w) * v1[3];
                        u32x4 w; w.x = cvt_pk_bf16(o0[0], o0[1]); w.y = cvt_pk_bf16(o0[2], o0[3]); w.z = cvt_pk_bf16(o1[0], o1[1]); w.w = cvt_pk_bf16(o1[2], o1[3]);
                        *(u32x4*)(MRG + off + bj * HALF) = w; } } }
        } else {
#pragma unroll
            for (int ai = 0; ai < 2; ++ai) {
              u32x4 gg[4][2], tt[4][2];
#pragma unroll
              for (int m = 0; m < 4; ++m)
#pragma unroll
                for (int bj = 0; bj < 2; ++bj) { const size_t o = (size_t)(row0 + ai * HALF + m * 16) * D + col0 + bj * HALF; gg[m][bj] = *(const u32x4*)(GB + o); tt[m][bj] = *(const u32x4*)(MRG + o); }
#pragma unroll
                for (int m = 0; m < 4; ++m) { const size_t off = (size_t)(row0 + ai * HALF + m * 16) * D + col0;
#pragma unroll
                    for (int bj = 0; bj < 2; ++bj) { const u32x4 g = gg[m][bj]; const f32x4 v0 = acc[ai][bj][m][0], v1 = acc[ai][bj][m][1];
                        const u32x4 tw = tt[m][bj]; const f32x4 t0 = {bf_lo(tw.x), bf_hi(tw.x), bf_lo(tw.y), bf_hi(tw.y)}, t1 = {bf_lo(tw.z), bf_hi(tw.z), bf_lo(tw.w), bf_hi(tw.w)};
                        f32x4 o0, o1; o0[0] = t0[0] + bf_lo(g.x) * v0[0]; o0[1] = t0[1] + bf_hi(g.x) * v0[1]; o0[2] = t0[2] + bf_lo(g.y) * v0[2]; o0[3] = t0[3] + bf_hi(g.y) * v0[3];
                        o1[0] = t1[0] + bf_lo(g.z) * v1[0]; o1[1] = t1[1] + bf_hi(g.z) * v1[1]; o1[2] = t1[2] + bf_lo(g.w) * v1[2]; o1[3] = t1[3] + bf_hi(g.w) * v1[3];
                        u32x4 w; w.x = cvt_pk_bf16(o0[0], o0[1]); w.y = cvt_pk_bf16(o0[2], o0[3]); w.z = cvt_pk_bf16(o1[0], o1[1]); w.w = cvt_pk_bf16(o1[2], o1[3]);
                        *(u32x4*)(MRG + off + bj * HALF) = w; } } }
        }
    }
};
template <bool BASE_BF> struct EpiResid {
    static constexpr bool RSLDS = false;
    const void* base; const float* gate; bf16_t* out; float scale;
    __device__ __forceinline__ void operator()(const f32x4 (&acc)[2][2][4][2], const Unit& u, int wr, int wc, int fr, int fq) const {
        const int row0 = u.pm * BM + wr * 64 + fr, col0 = u.pn * BM + wc * 32 + 8 * fq;
        const float* gv = gate + (size_t)(u.pm >> 4) * (NMOD * D) + col0;
        f32x4 g[2][2];
#pragma unroll
        for (int bj = 0; bj < 2; ++bj)
#pragma unroll
            for (int n = 0; n < 2; ++n) g[bj][n] = *(const f32x4*)(gv + bj * HALF + 4 * n);
#pragma unroll
        for (int ai = 0; ai < 2; ++ai) {
            f32x4 bs[4][2][2];
#pragma unroll
            for (int m = 0; m < 4; ++m)
#pragma unroll
                for (int bj = 0; bj < 2; ++bj) { const size_t o = (size_t)(row0 + ai * HALF + m * 16) * D + col0 + bj * HALF;
                    if constexpr (BASE_BF) { const u32x4 w = *(const u32x4*)((const bf16_t*)base + o); bs[m][bj][0] = (f32x4){bf_lo(w.x), bf_hi(w.x), bf_lo(w.y), bf_hi(w.y)}; bs[m][bj][1] = (f32x4){bf_lo(w.z), bf_hi(w.z), bf_lo(w.w), bf_hi(w.w)}; }
                    else { bs[m][bj][0] = *(const f32x4*)((const float*)base + o); bs[m][bj][1] = *(const f32x4*)((const float*)base + o + 4); } }
#pragma unroll
            for (int m = 0; m < 4; ++m)
#pragma unroll
                for (int bj = 0; bj < 2; ++bj) { const size_t o = (size_t)(row0 + ai * HALF + m * 16) * D + col0 + bj * HALF;
                    const f32x4 r0 = bs[m][bj][0] + g[bj][0] * (acc[ai][bj][m][0] * scale), r1 = bs[m][bj][1] + g[bj][1] * (acc[ai][bj][m][1] * scale);
                    u32x4 w; w.x = cvt_pk_bf16(r0[0], r0[1]); w.y = cvt_pk_bf16(r0[2], r0[3]); w.z = cvt_pk_bf16(r1[0], r1[1]); w.w = cvt_pk_bf16(r1[2], r1[3]); *(u32x4*)(out + o) = w; } }
    }
};
struct EpiStore32 {
    static constexpr bool RSLDS = false;
    float* out; int ldc; float scale;
    __device__ __forceinline__ void operator()(const f32x4 (&acc)[2][2][4][2], const Unit& u, int wr, int wc, int fr, int fq) const {
        const int row0 = u.pm * BM + wr * 64 + fr, col0 = u.pn * BM + wc * 32 + 4 * fq;
#pragma unroll
        for (int ai = 0; ai < 2; ++ai)
#pragma unroll
            for (int m = 0; m < 4; ++m) { float* rowp = out + (size_t)(row0 + ai * HALF + m * 16) * ldc + col0;
#pragma unroll
                for (int bj = 0; bj < 2; ++bj)
#pragma unroll
                    for (int n = 0; n < 2; ++n) *(f32x4*)(rowp + bj * HALF + n * 16) = acc[ai][bj][m][n] * scale; }
    }
};
struct EpiStore32Split {
    static constexpr bool RSLDS = false;
    bf16_t* out; int ldc; float scale; float* part;
    __device__ __forceinline__ void operator()(const f32x4 (&acc)[2][2][4][2], const Unit& u, int wr, int wc, int fr, int fq) const {
        const int row0 = wr * 64 + fr, col0 = wc * 32 + 8 * fq;
        if (u.part < 0) { bf16_t* base = out + (size_t)(u.pm * BM) * ldc + u.pn * BM;
#pragma unroll
            for (int ai = 0; ai < 2; ++ai)
#pragma unroll
                for (int m = 0; m < 4; ++m) { bf16_t* rowp = base + (size_t)(row0 + ai * HALF + m * 16) * ldc + col0;
#pragma unroll
                    for (int bj = 0; bj < 2; ++bj) { const f32x4 r0 = acc[ai][bj][m][0] * scale, r1 = acc[ai][bj][m][1] * scale;
                        u32x4 w; w.x = cvt_pk_bf16(r0[0], r0[1]); w.y = cvt_pk_bf16(r0[2], r0[3]); w.z = cvt_pk_bf16(r1[0], r1[1]); w.w = cvt_pk_bf16(r1[2], r1[3]); *(u32x4*)(rowp + bj * HALF) = w; } }
        } else { float* base = part + (size_t)u.part * (BM * BM);
#pragma unroll
            for (int ai = 0; ai < 2; ++ai)
#pragma unroll
                for (int m = 0; m < 4; ++m) { float* rowp = base + (size_t)(row0 + ai * HALF + m * 16) * BM + col0;
#pragma unroll
                    for (int bj = 0; bj < 2; ++bj)
#pragma unroll
                        for (int n = 0; n < 2; ++n) *(f32x4*)(rowp + bj * HALF + 4 * n) = acc[ai][bj][m][n] * scale; } }
    }
};
template <bool F8, bool I8IN> struct EpiGLU {
    static constexpr bool RSLDS = I8IN;
    void* out; int ldc; float s_in, s_out; const float* rowscale; const int* lists_base; const float* rsl; const LAS float* rs_lds;
    __device__ __forceinline__ const float* scale_src(const Unit& u) const { return u.rows ? rsl + (u.rows - lists_base) : rowscale + u.pm * BM; }
    __device__ __forceinline__ void operator()(const f32x4 (&acc)[2][2][4][2], const Unit& u, int wr, int wc, int fr, int fq) const {
        const int row0 = u.pm * BM + wr * 64 + fr, col0 = u.pn * HALF + wc * 32 + 8 * fq;
        float siv[2][4];
#pragma unroll
        for (int ai = 0; ai < 2; ++ai)
#pragma unroll
            for (int m = 0; m < 4; ++m) { siv[ai][m] = s_in;
                if constexpr (I8IN) siv[ai][m] = s_in * rs_lds[u.rsb + ai * HALF + wr * 64 + m * 16 + fr]; }
#pragma unroll
        for (int ai = 0; ai < 2; ++ai)
#pragma unroll
            for (int m = 0; m < 4; ++m) { const size_t off = (size_t)(row0 + ai * HALF + m * 16) * ldc + col0;
                const float si = siv[ai][m];
                f32x4 a00 = acc[ai][0][m][0], a01 = acc[ai][0][m][1], a10 = acc[ai][1][m][0], a11 = acc[ai][1][m][1];
                if constexpr (I8IN) {
                    const i32x4 b00 = __builtin_bit_cast(i32x4, a00), b01 = __builtin_bit_cast(i32x4, a01), b10 = __builtin_bit_cast(i32x4, a10), b11 = __builtin_bit_cast(i32x4, a11);
#pragma unroll
                    for (int j = 0; j < 4; ++j) { a00[j] = (float)b00[j]; a01[j] = (float)b01[j]; a10[j] = (float)b10[j]; a11[j] = (float)b11[j]; } }
                f32x4 y0, y1;
#pragma unroll
                for (int j = 0; j < 4; ++j) { y0[j] = silu_f(a00[j] * si) * (a01[j] * (si * s_out)); y1[j] = silu_f(a10[j] * si) * (a11[j] * (si * s_out)); }
                if constexpr (F8) { int w0 = 0, w1 = 0;
#pragma unroll
                    for (int j = 0; j < 4; ++j) { y0[j] = __builtin_amdgcn_fmed3f(y0[j], -448.0f, 448.0f); y1[j] = __builtin_amdgcn_fmed3f(y1[j], -448.0f, 448.0f); }
                    w0 = __builtin_amdgcn_cvt_pk_fp8_f32(y0[0], y0[1], w0, false); w0 = __builtin_amdgcn_cvt_pk_fp8_f32(y0[2], y0[3], w0, true);
                    w1 = __builtin_amdgcn_cvt_pk_fp8_f32(y1[0], y1[1], w1, false); w1 = __builtin_amdgcn_cvt_pk_fp8_f32(y1[2], y1[3], w1, true);
                    u32x2 w; w.x = (unsigned)w0; w.y = (unsigned)w1; *(u32x2*)((unsigned char*)out + off) = w; }
                else { u32x4 w; w.x = cvt_pk_bf16(y0[0], y0[1]); w.y = cvt_pk_bf16(y0[2], y0[3]); w.z = cvt_pk_bf16(y1[0], y1[1]); w.w = cvt_pk_bf16(y1[2], y1[3]);
                    *(u32x4*)((bf16_t*)out + off) = w; } }
    }
};
}

namespace att {
constexpr int KVB = 64;
constexpr int SHM_T = KVB * HD * 2;
constexpr int LDS_K = 0, LDS_V = 2 * SHM_T;
__device__ __forceinline__ int crow(int r, int hi) { return (r & 3) + 8 * (r >> 2) + 4 * hi; }
#define KSWZ(row, colB) ((row) * 256 + ((colB) ^ (((row) & 7) << 4)))
__device__ __forceinline__ int v_st(int k, int c) { const int kk = (k & ~0xC) | ((k & 4) << 1) | ((k & 8) >> 1); return ((kk >> 3) * 4 + (c >> 5)) * 512 + ((kk & 7) * 32 + (c & 31)) * 2; }
__device__ __forceinline__ int v_rd_base(int lane) { return ((lane & 3) << 3) | (((lane >> 2) & 3) << 6) | (((lane >> 4) & 1) << 5) | (((lane >> 5) & 1) << 8); }
constexpr int v_rd_off(int d0, int ks, int half) { return d0 * 512 + ks * 4096 + half * 2048; }
template <int OFF> __device__ __forceinline__ s16x4 tr_read(int vb) { s16x4 r; asm volatile("ds_read_b64_tr_b16 %0, %1 offset:%2" : "=&v"(r) : "v"(vb), "i"(OFF) : "memory"); return r; }
template <int D0> __device__ __forceinline__ void pv_one(f32x16& od, int vb, bf16x8 pa0, bf16x8 pa1, bf16x8 pa2, bf16x8 pa3) {
    const s16x4 l0 = tr_read<v_rd_off(D0, 0, 0)>(vb), h0 = tr_read<v_rd_off(D0, 0, 1)>(vb), l1 = tr_read<v_rd_off(D0, 1, 0)>(vb), h1 = tr_read<v_rd_off(D0, 1, 1)>(vb);
    const s16x4 l2 = tr_read<v_rd_off(D0, 2, 0)>(vb), h2 = tr_read<v_rd_off(D0, 2, 1)>(vb), l3 = tr_read<v_rd_off(D0, 3, 0)>(vb), h3 = tr_read<v_rd_off(D0, 3, 1)>(vb);
    asm volatile("s_waitcnt lgkmcnt(0)" ::: "memory"); __builtin_amdgcn_sched_barrier(0);
#define PK(L, H) (bf16x8){L[0], L[1], L[2], L[3], H[0], H[1], H[2], H[3]}
    od = __builtin_amdgcn_mfma_f32_32x32x16_bf16(pa0, PK(l0, h0), od, 0, 0, 0);
    od = __builtin_amdgcn_mfma_f32_32x32x16_bf16(pa1, PK(l1, h1), od, 0, 0, 0);
    od = __builtin_amdgcn_mfma_f32_32x32x16_bf16(pa2, PK(l2, h2), od, 0, 0, 0);
    od = __builtin_amdgcn_mfma_f32_32x32x16_bf16(pa3, PK(l3, h3), od, 0, 0, 0);
#undef PK
}
__device__ __forceinline__ void qkt(f32x16& p0, f32x16& p1, const LAS unsigned char* Ks, const bf16x8 (&qr)[8], int r32, int hi) {
    p0 = (f32x16){0.f, 0.f, 0.f, 0.f, 0.f, 0.f, 0.f, 0.f, 0.f, 0.f, 0.f, 0.f, 0.f, 0.f, 0.f, 0.f}; p1 = p0;
#pragma unroll
    for (int d0 = 0; d0 < 8; ++d0) { const int cb = (d0 * 16 + hi * 8) * 2;
        const bf16x8 b0 = *(const LAS bf16x8*)(Ks + KSWZ(r32, cb));
        const bf16x8 b1 = *(const LAS bf16x8*)(Ks + KSWZ(32 + r32, cb));
        p0 = __builtin_amdgcn_mfma_f32_32x32x16_bf16(b0, qr[d0], p0, 0, 0, 0);
        p1 = __builtin_amdgcn_mfma_f32_32x32x16_bf16(b1, qr[d0], p1, 0, 0, 0); }
}
__device__ __forceinline__ void sb_tile(f32x16& p0, f32x16& p1, float& C, int hi) {
    f32x2 a[16];
#pragma unroll
    for (int r = 0; r < 16; ++r) { a[r].x = frcp(1.0f + fexp2(p1[r])); a[r].y = frcp(1.0f + fexp2(p0[r])); }
    f32x2 s1v[4], s2v[4], s3v[4]; float tlo1[4], thi1[4], tlo0[4], thi0[4];
#pragma unroll
    for (int g = 0; g < 4; ++g) { s3v[g] = a[4 * g + 3]; s2v[g] = a[4 * g + 2] * s3v[g]; s1v[g] = a[4 * g + 1] * s2v[g]; const f32x2 s0 = a[4 * g] * s1v[g];
        const auto r1 = __builtin_amdgcn_permlane32_swap(__float_as_uint(s0.x), __float_as_uint(s0.x), false, false);
        const auto r0 = __builtin_amdgcn_permlane32_swap(__float_as_uint(s0.y), __float_as_uint(s0.y), false, false);
        tlo1[g] = __uint_as_float(r1[0]); thi1[g] = __uint_as_float(r1[1]); tlo0[g] = __uint_as_float(r0[0]); thi0[g] = __uint_as_float(r0[1]); }
    f32x2 off[4];
    { float c = C;
#pragma unroll
      for (int g = 3; g >= 0; --g) { off[g].x = hi ? c : c * thi1[g]; c *= tlo1[g] * thi1[g]; }
#pragma unroll
      for (int g = 3; g >= 0; --g) { off[g].y = hi ? c : c * thi0[g]; c *= tlo0[g] * thi0[g]; }
      C = c; }
#pragma unroll
    for (int g = 0; g < 4; ++g) {
        const f32x2 t3 = off[g], t2 = s3v[g] * off[g], t1 = s2v[g] * off[g], t0 = s1v[g] * off[g];
        const f32x2 w3 = t3 - a[4 * g + 3] * t3, w2 = t2 - a[4 * g + 2] * t2, w1 = t1 - a[4 * g + 1] * t1, w0 = t0 - a[4 * g] * t0;
        p1[4 * g + 3] = w3.x; p0[4 * g + 3] = w3.y; p1[4 * g + 2] = w2.x; p0[4 * g + 2] = w2.y; p1[4 * g + 1] = w1.x; p0[4 * g + 1] = w1.y; p1[4 * g] = w0.x; p0[4 * g] = w0.y;
    }
}
__device__ __forceinline__ void pack_p(const f32x16& p0, const f32x16& p1, bf16x8& pa0, bf16x8& pa1, bf16x8& pa2, bf16x8& pa3) {
#define PK4(P, BASE, OUT) do { unsigned a0 = cvt_pk_bf16(P[BASE + 0], P[BASE + 1]), a1 = cvt_pk_bf16(P[BASE + 2], P[BASE + 3]);   \
    unsigned b0 = cvt_pk_bf16(P[BASE + 4], P[BASE + 5]), b1 = cvt_pk_bf16(P[BASE + 6], P[BASE + 7]);                              \
    auto r0 = __builtin_amdgcn_permlane32_swap(a0, b0, false, false); auto r1 = __builtin_amdgcn_permlane32_swap(a1, b1, false, false); \
    u32x4 w = {r0[0], r1[0], r0[1], r1[1]}; OUT = *reinterpret_cast<bf16x8*>(&w); } while (0)
    PK4(p0, 0, pa0); PK4(p0, 8, pa1); PK4(p1, 0, pa2); PK4(p1, 8, pa3);
#undef PK4
}
__device__ __forceinline__ void unit(LAS unsigned char* lds, const bf16_t* __restrict__ Q, const bf16_t* __restrict__ Kg, const bf16_t* __restrict__ Vg, bf16_t* __restrict__ O, int b, int h, int qb) {
    const int tid = threadIdx.x, wid = __builtin_amdgcn_readfirstlane(tid >> 6), lane = tid & 63, r32 = lane & 31, hi = lane >> 5;
    const int q0 = qb * 256, NT = 4 * (qb + 1);
    const size_t tok0 = (size_t)b * SEQ;
    bf16x8 qr[8];
    { const bf16_t* Qw = Q + (tok0 + q0 + wid * 32 + r32) * 1024 + h * HD + hi * 8;
#pragma unroll
      for (int d0 = 0; d0 < 8; ++d0) qr[d0] = *(const bf16x8*)(Qw + d0 * 16); }
    f32x16 o[4];
#pragma unroll
    for (int d = 0; d < 4; ++d) o[d] = (f32x16){0.f, 0.f, 0.f, 0.f, 0.f, 0.f, 0.f, 0.f, 0.f, 0.f, 0.f, 0.f, 0.f, 0.f, 0.f, 0.f};
    float C = 1.0f;
    const int sr = tid >> 4, sc = (tid & 15) * 8, vst0 = v_st(sr, sc), vst1 = v_st(32 + sr, sc), kst0 = KSWZ(sr, sc * 2), kst1 = KSWZ(32 + sr, sc * 2);
    const bf16_t* Kh = Kg + tok0 * 1024 + h * HD + sc; const bf16_t* Vh = Vg + tok0 * 1024 + h * HD + sc;
    const int vbase = (int)(uintptr_t)(lds + LDS_V) + v_rd_base(lane);
    bf16x8 ka0, ka1, va0, va1, kb0, kb1, vb0, vb1;
#define SLOAD_A(j) do { const size_t k0_ = (size_t)(j) * KVB; ka0 = *(const bf16x8*)(Kh + (k0_ + sr) * 1024); ka1 = *(const bf16x8*)(Kh + (k0_ + 32 + sr) * 1024); \
        va0 = *(const bf16x8*)(Vh + (k0_ + sr) * 1024); va1 = *(const bf16x8*)(Vh + (k0_ + 32 + sr) * 1024); } while (0)
#define SLOAD_B(j) do { const size_t k0_ = (size_t)(j) * KVB; kb0 = *(const bf16x8*)(Kh + (k0_ + sr) * 1024); kb1 = *(const bf16x8*)(Kh + (k0_ + 32 + sr) * 1024); \
        vb0 = *(const bf16x8*)(Vh + (k0_ + sr) * 1024); vb1 = *(const bf16x8*)(Vh + (k0_ + 32 + sr) * 1024); } while (0)
#define SWRITE_A(bf) do { *(LAS bf16x8*)(lds + LDS_K + (bf) * SHM_T + kst0) = ka0; *(LAS bf16x8*)(lds + LDS_K + (bf) * SHM_T + kst1) = ka1; \
        *(LAS bf16x8*)(lds + LDS_V + (bf) * SHM_T + vst0) = va0; *(LAS bf16x8*)(lds + LDS_V + (bf) * SHM_T + vst1) = va1; } while (0)
#define SWRITE_B(bf) do { *(LAS bf16x8*)(lds + LDS_K + (bf) * SHM_T + kst0) = kb0; *(LAS bf16x8*)(lds + LDS_K + (bf) * SHM_T + kst1) = kb1; \
        *(LAS bf16x8*)(lds + LDS_V + (bf) * SHM_T + vst0) = vb0; *(LAS bf16x8*)(lds + LDS_V + (bf) * SHM_T + vst1) = vb1; } while (0)
    const int qmin = q0 + wid * 32, qrow = qmin + r32;
#define ATT_TILE(it_, bf_) do { const int j = NT - 1 - (it_), kmin = j * KVB; \
        if (kmin < qmin + 31) { f32x16 p0, p1; qkt(p0, p1, lds + LDS_K + (bf_) * SHM_T, qr, r32, hi); \
            if (kmin + 63 >= qmin) { _Pragma("unroll") for (int r = 0; r < 16; ++r) { const int key = kmin + crow(r, hi); p0[r] = key < qrow ? p0[r] : -__builtin_inff(); p1[r] = key + 32 < qrow ? p1[r] : -__builtin_inff(); } } \
            sb_tile(p0, p1, C, hi); bf16x8 pa0, pa1, pa2, pa3; pack_p(p0, p1, pa0, pa1, pa2, pa3); const int vb = vbase + (bf_) * SHM_T; \
            pv_one<0>(o[0], vb, pa0, pa1, pa2, pa3); pv_one<1>(o[1], vb, pa0, pa1, pa2, pa3); pv_one<2>(o[2], vb, pa0, pa1, pa2, pa3); pv_one<3>(o[3], vb, pa0, pa1, pa2, pa3); } } while (0)
    SLOAD_A(NT - 1); SWRITE_A(0); LDS_WAIT(); __builtin_amdgcn_s_barrier();
    SLOAD_A(NT - 2); SLOAD_B(NT - 3);
    for (int it = 0; it < NT; it += 2) {
        ATT_TILE(it, 0);
        SWRITE_A(1);
        LDS_WAIT(); __builtin_amdgcn_s_barrier();
        if (it + 3 < NT) SLOAD_A(NT - 4 - it);
        ATT_TILE(it + 1, 1);
        if (it + 2 < NT) SWRITE_B(0);
        LDS_WAIT(); __builtin_amdgcn_s_barrier();
        if (it + 4 < NT) SLOAD_B(NT - 5 - it);
    }
#undef SLOAD_A
#undef SLOAD_B
#undef SWRITE_A
#undef SWRITE_B
#undef ATT_TILE
    bf16_t* Ow = O + (tok0 + q0 + wid * 32) * 1024 + h * HD + r32;
#pragma unroll
    for (int r = 0; r < 16; ++r) { const int orow = crow(r, hi);
#pragma unroll
        for (int d0 = 0; d0 < 4; ++d0) Ow[(size_t)orow * 1024 + d0 * 32] = (bf16_t)(cvt_pk_bf16(o[d0][r], 0.f) & 0xffffu); }
}
}

constexpr int VT_PITCH = 272;
__device__ __forceinline__ void gate_unit(LAS unsigned char* lds, const bf16_t* __restrict__ VS, const bf16_t* __restrict__ U, const float* __restrict__ rsvs, const float* __restrict__ sgg,
                                          const bf16_t* __restrict__ Wt, const float* __restrict__ bs, bf16_t* __restrict__ Y, int n, int g) {
    const int tid = threadIdx.x, wid = __builtin_amdgcn_readfirstlane(tid >> 6), lane = tid & 63, r32 = lane & 31, hi = lane >> 5;
    const size_t tok0 = (size_t)n * 128;
    { const int s = tid >> 2, cb = (tid & 3) * 32; const f32x4 sq = *(const f32x4*)(rsvs + (tok0 + s) * 4); const float rs = 1.0f / sqrtf(((sq[0] + sq[1]) + (sq[2] + sq[3])) * (1.0f / SGW) + EPS); const bf16_t* src = VS + (tok0 + s) * 1024 + g * 128 + cb;
#pragma unroll
      for (int i = 0; i < 4; ++i) { const u32x4 w = *(const u32x4*)(src + 8 * i); const f32x4 g0 = *(const f32x4*)(sgg + g * 128 + cb + 8 * i), g1 = *(const f32x4*)(sgg + g * 128 + cb + 8 * i + 4);
          float v[8] = {bf_lo(w.x) * rs * g0[0], bf_hi(w.x) * rs * g0[1], bf_lo(w.y) * rs * g0[2], bf_hi(w.y) * rs * g0[3], bf_lo(w.z) * rs * g1[0], bf_hi(w.z) * rs * g1[1], bf_lo(w.w) * rs * g1[2], bf_hi(w.w) * rs * g1[3]};
#pragma unroll
          for (int e = 0; e < 8; ++e) *(LAS bf16_t*)(lds + (cb + 8 * i + e) * VT_PITCH + s * 2) = (bf16_t)(cvt_pk_bf16(v[e], 0.f) & 0xffffu); } }
    LDS_WAIT(); __builtin_amdgcn_s_barrier();
    const int tt = wid >> 1, ct0 = (wid & 1) * 2;
    f32x16 acc0 = (f32x16){0.f, 0.f, 0.f, 0.f, 0.f, 0.f, 0.f, 0.f, 0.f, 0.f, 0.f, 0.f, 0.f, 0.f, 0.f, 0.f}, acc1 = acc0;
    const bf16_t* Wrow = Wt + ((size_t)g * 128 + tt * 32 + r32) * 128 + hi * 8;
#pragma unroll
    for (int ks = 0; ks < 8; ++ks) {
        if (16 * ks <= 32 * tt + 31) {
            const bf16x8 a = *(const bf16x8*)(Wrow + ks * 16);
            const bf16x8 b0 = *(const LAS bf16x8*)(lds + (ct0 * 32 + r32) * VT_PITCH + (ks * 16 + hi * 8) * 2);
            const bf16x8 b1 = *(const LAS bf16x8*)(lds + (ct0 * 32 + 32 + r32) * VT_PITCH + (ks * 16 + hi * 8) * 2);
            acc0 = __builtin_amdgcn_mfma_f32_32x32x16_bf16(a, b0, acc0, 0, 0, 0);
            acc1 = __builtin_amdgcn_mfma_f32_32x32x16_bf16(a, b1, acc1, 0, 0, 0);
        }
    }
#pragma unroll
    for (int r = 0; r < 16; ++r) { const int t = tt * 32 + att::crow(r, hi); const float bb = bs[g * 128 + t];
        const size_t o0 = (tok0 + t) * 1024 + g * 128 + ct0 * 32 + r32;
        const float u0 = bf_lo((unsigned)U[o0]), u1 = bf_lo((unsigned)U[o0 + 32]);
        Y[o0] = (bf16_t)(cvt_pk_bf16(u0 * (acc0[r] + bb), 0.f) & 0xffffu); Y[o0 + 32] = (bf16_t)(cvt_pk_bf16(u1 * (acc1[r] + bb), 0.f) & 0xffffu); }
    LDS_WAIT(); __builtin_amdgcn_s_barrier();
}

template <int MAP  > __device__ __forceinline__ int rowmap(int c, int nsel) {
    if (MAP == 0) return c;
    if (MAP == 1) { const int c32 = c & 31; return (c & ~31) + 16 * ((c32 >> 2) & 1) + 4 * (c32 >> 3) + (c32 & 3); }
    const int pn = c >> 7, wc = (c >> 5) & 3, fq = (c >> 3) & 3, bj = (c >> 2) & 1, j = c & 3;
    return 256 * pn + 128 * bj + 32 * wc + 16 * nsel + 4 * fq + j;
}
__device__ __forceinline__ int rowmap_rt(int map, int c, int nsel) { return map == 0 ? rowmap<0>(c, nsel) : map == 1 ? rowmap<1>(c, nsel) : rowmap<2>(c, nsel); }
constexpr int CT_PITCH = 528;
constexpr int J_IN = 8 * 72, J_PJ = 4 * 16, J_WO = 8 * 16, J_F1 = 8 * 44, J_F2 = 22 * 16, J_M1 = 8 * 56, J_M2 = 28 * 16;
constexpr int J_LAYER = J_IN + 2 * J_PJ + J_WO, J_FFN = 2 * J_F1 + J_F2, J_EXP = 2 * J_M1 + J_M2, NITEMS = NL * J_LAYER + J_FFN + NE * J_EXP;
constexpr int N_ADA_ITEMS = NL * (NMOD * D) / 256;

struct Args { const float* in[22]; float* out; unsigned char* ws; int ph_lo, ph_hi; };
struct CvtJob { const float* W; bf16_t* dst; int K, N, map, nsel, k0, n0, f8; };

__device__ __forceinline__ void p0_decode(const Args& a, int it, CvtJob& j) {
    unsigned char* ws = a.ws; int r = it; const float* W; bf16_t* dst; int K, N, map, nsel = 0, f8 = 0;
    if (r < NL * J_LAYER) { const int l = r / J_LAYER; r -= l * J_LAYER;
        if (r < J_IN) { W = a.in[6] + (size_t)l * D * NIN; K = D; N = NIN; dst = (bf16_t*)(ws + WS_WIN + (size_t)l * NIN * D); map = 1; f8 = 2; }
        else if ((r -= J_IN) < J_PJ) { W = a.in[12] + (size_t)l * SBW * D; K = SBW; N = D; dst = (bf16_t*)(ws + WS_WPSB) + (size_t)l * D * SBW; map = 1; }
        else if ((r -= J_PJ) < J_PJ) { W = a.in[13] + (size_t)l * SGW * D; K = SGW; N = D; dst = (bf16_t*)(ws + WS_WPSG) + (size_t)l * D * SGW; map = 1; }
        else { r -= J_PJ; W = a.in[14] + (size_t)l * D * D; K = D; N = D; dst = (bf16_t*)(ws + WS_WOUT) + (size_t)l * D * D; map = 1; } }
    else if ((r -= NL * J_LAYER) < J_FFN) {
        if (r < J_F1) { W = a.in[15]; K = D; N = FD; dst = (bf16_t*)(ws + WS_WF13); map = 2; nsel = 0; f8 = 2; }
        else if ((r -= J_F1) < J_F1) { W = a.in[16]; K = D; N = FD; dst = (bf16_t*)(ws + WS_WF13); map = 2; nsel = 1; f8 = 2; }
        else { r -= J_F1; W = a.in[17]; K = FD; N = D; dst = (bf16_t*)(ws + WS_WF2); map = 1; f8 = FFN0_F8; } }
    else { r -= J_FFN; int e;
        if (r < NE * 2 * J_M1) { e = r / (2 * J_M1); r -= e * 2 * J_M1; } else { r -= NE * 2 * J_M1; e = r / J_M2; r -= e * J_M2; r += 2 * J_M1; }
        if (r < J_M1) { W = a.in[19] + (size_t)e * D * FE; K = D; N = FE; dst = (bf16_t*)(ws + WS_WM13 + (size_t)e * 2 * FE * D); map = 2; nsel = 0; f8 = 2; }
        else if ((r -= J_M1) < J_M1) { W = a.in[20] + (size_t)e * D * FE; K = D; N = FE; dst = (bf16_t*)(ws + WS_WM13 + (size_t)e * 2 * FE * D); map = 2; nsel = 1; f8 = 2; }
        else { r -= J_M1; W = a.in[21] + (size_t)e * FE * D; K = FE; N = D; dst = (bf16_t*)(ws + WS_WM2 + (size_t)e * D * FE); map = 1; f8 = 1; } }
    const int nblk = N >> 7, kb = r / nblk, nb = r - kb * nblk;
    j.W = W; j.dst = dst; j.K = K; j.N = N; j.map = map; j.nsel = nsel; j.k0 = kb * 256; j.n0 = nb * 128; j.f8 = f8;
}
__device__ __forceinline__ void p0_tile_load(const CvtJob& j, f32x4 (&v)[16], int tid) {
    const float* src = j.W + (size_t)(j.k0 + 16 * (tid >> 5)) * j.N + j.n0 + 4 * (tid & 31);
#pragma unroll
    for (int i = 0; i < 16; ++i) v[i] = __builtin_nontemporal_load((const f32x4*)(src + (size_t)i * j.N));
}
__device__ __forceinline__ unsigned pack_i8(float a, float b, float c, float d) {
    const float M = 12582912.0f;
    const unsigned ua = __float_as_uint(__builtin_amdgcn_fmed3f(a, -127.f, 127.f) + M), ub = __float_as_uint(__builtin_amdgcn_fmed3f(b, -127.f, 127.f) + M);
    const unsigned uc = __float_as_uint(__builtin_amdgcn_fmed3f(c, -127.f, 127.f) + M), ud = __float_as_uint(__builtin_amdgcn_fmed3f(d, -127.f, 127.f) + M);
    return (ua & 0xffu) | ((ub & 0xffu) << 8) | ((uc & 0xffu) << 16) | (ud << 24);
}
__device__ __forceinline__ void p0_tile_to_lds(const f32x4 (&v)[16], LAS unsigned char* lds, int tid, int f8) {
    const int kq = tid >> 5, nq = tid & 31;
    if (f8 == 2) {
#pragma unroll
        for (int jn = 0; jn < 4; ++jn) { unsigned w[4];
#pragma unroll
            for (int q = 0; q < 4; ++q) w[q] = pack_i8(v[4 * q][jn] * WI8_SCALE, v[4 * q + 1][jn] * WI8_SCALE, v[4 * q + 2][jn] * WI8_SCALE, v[4 * q + 3][jn] * WI8_SCALE);
            u32x4 o; o.x = w[0]; o.y = w[1]; o.z = w[2]; o.w = w[3];
            *(LAS u32x4*)(lds + (4 * nq + jn) * CT_PITCH + kq * 16) = o; }
    } else if (f8) {
#pragma unroll
        for (int jn = 0; jn < 4; ++jn) { int w[4];
#pragma unroll
            for (int q = 0; q < 4; ++q) { int x = 0; x = __builtin_amdgcn_cvt_pk_fp8_f32(v[4 * q][jn] * W8_SCALE, v[4 * q + 1][jn] * W8_SCALE, x, false); x = __builtin_amdgcn_cvt_pk_fp8_f32(v[4 * q + 2][jn] * W8_SCALE, v[4 * q + 3][jn] * W8_SCALE, x, true); w[q] = x; }
            u32x4 o; o.x = (unsigned)w[0]; o.y = (unsigned)w[1]; o.z = (unsigned)w[2]; o.w = (unsigned)w[3];
            *(LAS u32x4*)(lds + (4 * nq + jn) * CT_PITCH + kq * 16) = o; }
    } else {
#pragma unroll
        for (int jn = 0; jn < 4; ++jn) {
            u32x4 lo, hi;
            lo.x = cvt_pk_bf16(v[0][jn], v[1][jn]); lo.y = cvt_pk_bf16(v[2][jn], v[3][jn]); lo.z = cvt_pk_bf16(v[4][jn], v[5][jn]); lo.w = cvt_pk_bf16(v[6][jn], v[7][jn]);
            hi.x = cvt_pk_bf16(v[8][jn], v[9][jn]); hi.y = cvt_pk_bf16(v[10][jn], v[11][jn]); hi.z = cvt_pk_bf16(v[12][jn], v[13][jn]); hi.w = cvt_pk_bf16(v[14][jn], v[15][jn]);
            LAS unsigned char* p = lds + (4 * nq + jn) * CT_PITCH + kq * 32;
            *(LAS u32x4*)p = lo; *(LAS u32x4*)(p + 16) = hi;
        }
    }
}
__device__ __forceinline__ void p0_tile_store(const CvtJob& j, const LAS unsigned char* lds, int tid) {
    if (j.f8) {
        const int kc = tid & 15, nr = tid >> 4;
#pragma unroll
        for (int i2 = 0; i2 < 4; ++i2) { const int n = nr + 32 * i2; const u32x4 t = *(const LAS u32x4*)(lds + n * CT_PITCH + kc * 16);
            const int rho = rowmap_rt(j.map, j.n0 + n, j.nsel); __builtin_nontemporal_store(t, (u32x4*)((unsigned char*)j.dst + (size_t)rho * j.K + j.k0 + 16 * kc)); }
    } else {
        const int kc = tid & 31, nr = tid >> 5;
#pragma unroll
        for (int i2 = 0; i2 < 8; ++i2) { const int n = nr + 16 * i2; const u32x4 t = *(const LAS u32x4*)(lds + n * CT_PITCH + kc * 16);
            const int rho = rowmap_rt(j.map, j.n0 + n, j.nsel); __builtin_nontemporal_store(t, (u32x4*)(j.dst + (size_t)rho * j.K + j.k0 + 8 * kc)); }
    }
}
__device__ __forceinline__ void p0_adaln_item(const Args& a, int ai, const LAS float* cact, LAS float* red, int tid) {
    const int wave = tid >> 6, lane = tid & 63;
    const int l = ai / (N_ADA_ITEMS / NL), j0 = (ai % (N_ADA_ITEMS / NL)) * 256 + 4 * lane;
    const float* w = a.in[2] + (size_t)l * D * (NMOD * D) + (size_t)(wave * 256) * (NMOD * D) + j0;
    f32x4 acc0 = {0.f, 0.f, 0.f, 0.f}, acc1 = {0.f, 0.f, 0.f, 0.f};
    for (int k = 0; k < 256; k += 16) {
        f32x4 wv[16];
#pragma unroll
        for (int i = 0; i < 16; ++i) wv[i] = *(const f32x4*)(w + (size_t)(k + i) * (NMOD * D));
#pragma unroll
        for (int i = 0; i < 16; ++i) { const float c0 = cact[wave * 256 + k + i], c1 = cact[D + wave * 256 + k + i]; acc0 += c0 * wv[i]; acc1 += c1 * wv[i]; }
    }
    *(LAS f32x4*)(red + (wave * 2 + 0) * 256 + 4 * lane) = acc0; *(LAS f32x4*)(red + (wave * 2 + 1) * 256 + 4 * lane) = acc1;
    LDS_WAIT(); __syncthreads();
    { const int b = tid >> 8, c = tid & 255; float s = 0.f;
#pragma unroll
      for (int wv = 0; wv < 8; ++wv) s += red[(wv * 2 + b) * 256 + c];
      const int jj = (ai % (N_ADA_ITEMS / NL)) * 256 + c;
      ((float*)(a.ws + WS_MOD))[(size_t)l * NB * (NMOD * D) + (size_t)b * (NMOD * D) + jj] = s + a.in[3][(size_t)l * (NMOD * D) + jj]; }
    __syncthreads();
}

__device__ __forceinline__ bool convert_pool(const Args& args, LAS unsigned char* lds, volatile LAS int* nextw, unsigned* ctr, int first, int last, int maxn = 0x7fffffff) {
    const int tid = threadIdx.x;
    if (maxn <= 0) return true;
    int nclaimed = 1;
    if (tid == 0) nextw[0] = first + (int)__hip_atomic_fetch_add(ctr, 1u, RLX_AGENT);
    LDS_WAIT(); __syncthreads();
    int it = nextw[0];
    CvtJob cur, nxt; f32x4 v[16];
    if (it < last) { p0_decode(args, it, nxt); p0_tile_load(nxt, v, tid); }
    while (it < last) {
        cur = nxt;
        p0_tile_to_lds(v, lds, tid, cur.f8);
        if (tid == 0) nextw[1] = nclaimed < maxn ? first + (int)__hip_atomic_fetch_add(ctr, 1u, RLX_AGENT) : last;
        ++nclaimed;
        LDS_WAIT(); __syncthreads();
        it = nextw[1];
        if (it < last) { p0_decode(args, it, nxt); p0_tile_load(nxt, v, tid); }
        p0_tile_store(cur, lds, tid);
        LDS_WAIT(); __syncthreads();
    }
    return nclaimed > maxn;
}
constexpr int CV_MID = 4;
constexpr int NDEFER_DU = 768;
constexpr int NDEFER_W2 = NE * J_M2;
constexpr int MOEUP_CONV = 16;
constexpr int NDEFER0 = 3200, NDEFER1 = 3200, NDEFER = NDEFER0 + NDEFER1 + NDEFER_DU + NDEFER_W2;
static_assert(NDEFER <= NE * J_EXP, "only expert weights may be deferred");

template <bool ROUTER, bool I8OUT, bool XBF  >
__device__ __forceinline__ void norm_phase(const void* __restrict__ xin, const float* __restrict__ gain, const float* __restrict__ mod_shift, const float* __restrict__ mod_scale, bf16_t* __restrict__ hn,
                                           const float* __restrict__ wrouter, unsigned char* ws, LAS unsigned char* lds, int G, float* __restrict__ rs8 = nullptr) {
    const int tid = threadIdx.x, wave = __builtin_amdgcn_readfirstlane(tid >> 6), lane = tid & 63;
    const int gw = blockIdx.x * NWAVES + wave, NGW = G * NWAVES;
    LAS float* WR = (LAS float*)lds;
    if (ROUTER) {
        for (int i = tid; i < D * NE; i += NTHREADS) { const int d = i >> 3, e = i & 7; WR[e * D + d] = wrouter[i]; }
        LDS_WAIT(); __builtin_amdgcn_s_barrier();
    }
    const int b = gw & 1;
    f32x4 cA[8], cS[8];
#pragma unroll
    for (int i = 0; i < 8; ++i) { const int e = 4 * lane + 256 * i; const f32x4 g = *(const f32x4*)(gain + e), sc = *(const f32x4*)(mod_scale + (size_t)b * (NMOD * D) + e);
        cA[i] = g * (1.0f + sc); cS[i] = *(const f32x4*)(mod_shift + (size_t)b * (NMOD * D) + e); }
    for (int r = gw >> 1; r < SEQ; r += NGW >> 1) {
        const int t = b * SEQ + r;
        f32x4 v[8]; float ss = 0.f;
#pragma unroll
        for (int i = 0; i < 8; ++i) {
            if constexpr (XBF) { const u32x2 w = *(const u32x2*)((const bf16_t*)xin + (size_t)t * D + 4 * lane + 256 * i); v[i] = (f32x4){bf_lo(w.x), bf_hi(w.x), bf_lo(w.y), bf_hi(w.y)}; }
            else v[i] = *(const f32x4*)((const float*)xin + (size_t)t * D + 4 * lane + 256 * i);
            ss += (v[i][0] * v[i][0] + v[i][1] * v[i][1]) + (v[i][2] * v[i][2] + v[i][3] * v[i][3]); }
        const float rstd = 1.0f / sqrtf(wave_sum(ss) * (1.0f / D) + EPS);
        bf16_t* orow = hn + (size_t)t * D + 4 * lane;
#pragma unroll
        for (int i = 0; i < 8; ++i) v[i] = v[i] * rstd * cA[i] + cS[i];
        float rowsc = 0.f;
        if constexpr (I8OUT) {
            float am = 0.f;
#pragma unroll
            for (int i = 0; i < 8; ++i) am = fmaxf(fmaxf(am, fmaxf(fabsf(v[i][0]), fabsf(v[i][1]))), fmaxf(fabsf(v[i][2]), fabsf(v[i][3])));
#pragma unroll
            for (int o = 1; o < 64; o <<= 1) am = fmaxf(am, __shfl_xor(am, o));
            const float inv = am > 0.f ? 127.0f / am : 0.f;
            unsigned char* o8 = (unsigned char*)hn + (size_t)t * D + 4 * lane;
#pragma unroll
            for (int i = 0; i < 8; ++i) *(unsigned*)(o8 + 256 * i) = pack_i8(v[i][0] * inv, v[i][1] * inv, v[i][2] * inv, v[i][3] * inv);
            rowsc = am * (1.0f / 127.0f);
            if (lane == 0) rs8[t] = rowsc;
        } else {
#pragma unroll
            for (int i = 0; i < 8; ++i) { u32x2 w; w.x = cvt_pk_bf16(v[i][0], v[i][1]); w.y = cvt_pk_bf16(v[i][2], v[i][3]); *(u32x2*)(orow + 256 * i) = w; }
        }
        if (ROUTER) {
            asm volatile("" ::: "memory");
            float lg[NE];
#pragma unroll
            for (int e = 0; e < NE; ++e) { float s = 0.f;
#pragma unroll
                for (int i = 0; i < 8; ++i) { const f32x4 w = *(const LAS f32x4*)(WR + e * D + 4 * lane + 256 * i); s += (v[i][0] * w[0] + v[i][1] * w[1]) + (v[i][2] * w[2] + v[i][3] * w[3]); }
                lg[e] = wave_sum(s); }
            int e0 = 0; float v0 = lg[0];
#pragma unroll
            for (int e = 1; e < NE; ++e) if (lg[e] > v0) { v0 = lg[e]; e0 = e; }
            int e1 = -1; float v1 = -__builtin_inff();
#pragma unroll
            for (int e = 0; e < NE; ++e) if (e != e0 && lg[e] > v1) { v1 = lg[e]; e1 = e; }
            const float g0 = 1.0f / (1.0f + expf(v1 - v0)), g1 = 1.0f - g0;
            if (lane == 0) {
                unsigned* cnt = (unsigned*)(ws + WS_CTL) + CW_CNT;
                int* tok_e = (int*)(ws + WS_ROUTE); float* tok_g = (float*)(ws + WS_ROUTE + (size_t)T * 8); int* tok_pos = (int*)(ws + WS_ROUTE + (size_t)T * 16); int* lists = (int*)(ws + WS_ROUTE + (size_t)T * 24);
                const int p0 = (int)__hip_atomic_fetch_add(cnt + 64 * e0, 1u, RLX_AGENT), p1 = (int)__hip_atomic_fetch_add(cnt + 64 * e1, 1u, RLX_AGENT);
                lists[(size_t)e0 * T + p0] = t; lists[(size_t)e1 * T + p1] = t;
                float* rsl = (float*)(ws + WS_ROUTE + 512 * 1024); rsl[(size_t)e0 * T + p0] = rowsc; rsl[(size_t)e1 * T + p1] = rowsc;
                tok_e[2 * t] = e0; tok_e[2 * t + 1] = e1; tok_g[2 * t] = g0; tok_g[2 * t + 1] = g1; tok_pos[2 * t] = p0; tok_pos[2 * t + 1] = p1;
            }
        }
    }
}
__device__ __forceinline__ void post_phase(bf16_t* __restrict__ Q, bf16_t* __restrict__ Kb, const bf16_t* __restrict__ VS, float* __restrict__ rsvs, const float* __restrict__ gq, const float* __restrict__ gk, int G) {
    const int tid = threadIdx.x, wave = __builtin_amdgcn_readfirstlane(tid >> 6), lane = tid & 63;
    const int gw = blockIdx.x * NWAVES + wave, NGW = G * NWAVES;
    const int d0 = (lane & 15) * 8;
    float cq[8], ck[8];
#pragma unroll
    for (int j = 0; j < 8; ++j) { cq[j] = gq[d0 + j] * QSCALE; ck[j] = gk[d0 + j]; }
    for (int t = gw; t < T; t += NGW) {
#pragma unroll
        for (int which = 0; which < 2; ++which) {
            bf16_t* row = (which ? Kb : Q) + (size_t)t * 1024 + lane * 8;
#pragma unroll
            for (int i = 0; i < 2; ++i) { const u32x4 w = *(const u32x4*)(row + 512 * i);
                float v[8] = {bf_lo(w.x), bf_hi(w.x), bf_lo(w.y), bf_hi(w.y), bf_lo(w.z), bf_hi(w.z), bf_lo(w.w), bf_hi(w.w)};
                float ss = 0.f;
#pragma unroll
                for (int j = 0; j < 8; ++j) ss += v[j] * v[j];
                ss += __shfl_xor(ss, 1); ss += __shfl_xor(ss, 2); ss += __shfl_xor(ss, 4); ss += __shfl_xor(ss, 8);
                const float rstd = 1.0f / sqrtf(ss * (1.0f / HD) + EPS);
#pragma unroll
                for (int j = 0; j < 8; ++j) v[j] = v[j] * rstd * (which ? ck[j] : cq[j]);
                u32x4 o; o.x = cvt_pk_bf16(v[0], v[1]); o.y = cvt_pk_bf16(v[2], v[3]); o.z = cvt_pk_bf16(v[4], v[5]); o.w = cvt_pk_bf16(v[6], v[7]);
                *(u32x4*)(row + 512 * i) = o; }
        }
        { const bf16_t* row = VS + (size_t)t * 1024 + lane * 8; float ss = 0.f;
#pragma unroll
          for (int i = 0; i < 2; ++i) { const u32x4 w = *(const u32x4*)(row + 512 * i);
              const float v[8] = {bf_lo(w.x), bf_hi(w.x), bf_lo(w.y), bf_hi(w.y), bf_lo(w.z), bf_hi(w.z), bf_lo(w.w), bf_hi(w.w)};
#pragma unroll
              for (int j = 0; j < 8; ++j) ss += v[j] * v[j]; }
          ss = wave_sum(ss);
          if (lane == 0) rsvs[t] = 1.0f / sqrtf(ss * (1.0f / SGW) + EPS); }
    }
}
__device__ __forceinline__ void moe_tables(unsigned char* ws, volatile LAS int* tab) {
    if (threadIdx.x == 0) {
        unsigned* cnt = (unsigned*)(ws + WS_CTL) + CW_CNT; int rt = 0;
        for (int e = 0; e < NE; ++e) { const int c = (int)__hip_atomic_load(cnt + 64 * e, RLX_AGENT); tab[e] = rt; tab[16 + e] = c; const int n = (c + 255) >> 8; for (int i = 0; i < n; ++i) tab[32 + rt + i] = e; rt += n; }
        tab[8] = rt;
        const int G = (int)gridDim.x, nwg = rt * (D / 256), full = (nwg / G) * G, R = nwg - full;
        tab[9] = R == 0 ? 1 : R * 7 <= G ? 7 : R * 4 <= G ? 4 : R * 2 <= G ? 2 : 1; tab[10] = full;
    }
    LDS_WAIT(); __syncthreads();
}
__device__ __forceinline__ void combine_phase(const bf16_t* __restrict__ x1, const float* __restrict__ gate, const bf16_t* __restrict__ YM, const float* __restrict__ PART, float* __restrict__ out, unsigned char* ws, volatile LAS int* tab, int G) {
    const int tid = threadIdx.x, wave = __builtin_amdgcn_readfirstlane(tid >> 6), lane = tid & 63;
    const int nM = __builtin_amdgcn_readfirstlane(tab[8]), S = __builtin_amdgcn_readfirstlane(tab[9]), full = __builtin_amdgcn_readfirstlane(tab[10]), nwg = nM * (D / 256);
    for (int i = tid; i < nwg; i += NTHREADS) tab[128 + i] = -1;
    LDS_WAIT(); __syncthreads();
    if (S > 1) for (int j = tid; j < nwg - full; j += NTHREADS) { int pm, pn; pg8::tile_of(full + j, nM, D / 256, pm, pn); tab[128 + 8 * pm + pn] = j; }
    LDS_WAIT(); __syncthreads();
    const int gw = blockIdx.x * NWAVES + wave, NGW = G * NWAVES;
    const int* tok_e = (const int*)(ws + WS_ROUTE); const float* tok_g = (const float*)(ws + WS_ROUTE + (size_t)T * 8); const int* tok_pos = (const int*)(ws + WS_ROUTE + (size_t)T * 16);
    for (int t = gw; t < T; t += NGW) {
        const int e0 = tok_e[2 * t], e1 = tok_e[2 * t + 1]; const float g0 = tok_g[2 * t], g1 = tok_g[2 * t + 1];
        const size_t r0 = (size_t)tab[e0] * 256 + tok_pos[2 * t], r1 = (size_t)tab[e1] * 256 + tok_pos[2 * t + 1];
        const bf16_t* y0 = YM + r0 * D + 4 * lane; const bf16_t* y1 = YM + r1 * D + 4 * lane; const bf16_t* xr = x1 + (size_t)t * D + 4 * lane; const float* gv = gate + (size_t)(t >> 12) * (NMOD * D) + 4 * lane;
        float* orow = out + (size_t)t * D + 4 * lane;
#pragma unroll
        for (int i = 0; i < 8; ++i) { const u32x2 wa = *(const u32x2*)(y0 + 256 * i), wc = *(const u32x2*)(y1 + 256 * i), wx = *(const u32x2*)(xr + 256 * i);
            f32x4 a = {bf_lo(wa.x), bf_hi(wa.x), bf_lo(wa.y), bf_hi(wa.y)}, c = {bf_lo(wc.x), bf_hi(wc.x), bf_lo(wc.y), bf_hi(wc.y)}; const f32x4 x = {bf_lo(wx.x), bf_hi(wx.x), bf_lo(wx.y), bf_hi(wx.y)}, g = *(const f32x4*)(gv + 256 * i);
            const int j0 = __builtin_amdgcn_readfirstlane(tab[128 + 8 * (int)(r0 >> 8) + i]), j1 = __builtin_amdgcn_readfirstlane(tab[128 + 8 * (int)(r1 >> 8) + i]);
            if (j0 >= 0) { const float* p = PART + (size_t)j0 * (S - 1) * 65536 + (r0 & 255) * 256 + 4 * lane; for (int k = 0; k < S - 1; ++k) a += *(const f32x4*)(p + (size_t)k * 65536); }
            if (j1 >= 0) { const float* p = PART + (size_t)j1 * (S - 1) * 65536 + (r1 & 255) * 256 + 4 * lane; for (int k = 0; k < S - 1; ++k) c += *(const f32x4*)(p + (size_t)k * 65536); }
            __builtin_nontemporal_store((f32x4)(x + g * (g0 * a + g1 * c)), (f32x4*)(orow + 256 * i)); }
    }
}

#ifdef ONLY_PHASE
#ifndef ONLY_LAYER
#define ONLY_LAYER -1
#endif
#define IN(k) ((((k) - 1) % 10 + 1 == ONLY_PHASE || (k) == ONLY_PHASE) && (ONLY_LAYER < 0 || ((k) - 1) / 10 == ONLY_LAYER) && lo <= (k) && (k) < hi)
#else
#define IN(k) (lo <= (k) && (k) < hi)
#endif
#define SEAM(k) do { if ((k) + 1 < hi) xcd_barrier(bar); } while (0)
constexpr int NPHASE_FWD = 21;
template <int L>
__device__ __forceinline__ void layer_phases(const Args& args, LAS unsigned char* lds, volatile LAS int* moetab, const XcdBarrier& bar, const int lo, const int hi, const int G) {
    unsigned char* ws = args.ws;
        constexpr int l = L; constexpr int pb = 1 + 10 * l;
        const void* xin = l == 0 ? (const void*)args.in[0] : (const void*)(ws + WS_X2);
        const float* mod = (const float*)(ws + WS_MOD) + (size_t)l * NB * (NMOD * D);
        bf16_t* HN = (bf16_t*)(ws + WS_HN);
        bf16_t *Qb = (bf16_t*)(ws + WS_Q), *Kb = (bf16_t*)(ws + WS_K), *Vb = (bf16_t*)(ws + WS_V), *Ub = (bf16_t*)(ws + WS_U), *VSb = (bf16_t*)(ws + WS_VS), *GAb = (bf16_t*)(ws + WS_GA), *GBb = (bf16_t*)(ws + WS_GB);
        bf16_t *YSB = (bf16_t*)(ws + WS_YSB), *YSG = (bf16_t*)(ws + WS_YSG), *MRG = (bf16_t*)(ws + WS_MRG);
        bf16_t *X1 = (bf16_t*)(ws + WS_X1), *X2 = (bf16_t*)(ws + WS_X2); float* RSVS = (float*)(ws + WS_RSVS);

        if (IN(pb + 0)) { for (int rep_ = 0; rep_ < ((PROBE_REPEAT & 8) ? 2 : 1); ++rep_) norm_phase<false, true, l != 0>(xin, args.in[4] + (size_t)l * D, mod + 0 * D, mod + 1 * D, (bf16_t*)(ws + WS_HN8A + (size_t)l * T * D), nullptr, ws, lds, G, (float*)(ws + WS_RS8A) + (size_t)l * T); SEAM(pb + 0); }
        if (IN(pb + 1)) {
            pg8::DenseOrder S{(const char*)(ws + WS_HN8A + (size_t)l * T * D), (const char*)(ws + WS_WIN) + (size_t)l * NIN * D, T / 256, pg8::DYN_PN0, G, (int)blockIdx.x, (size_t)256 * D, (size_t)256 * D, GSH(0)};
            pg8::EpiInProj1 E{Qb, GAb, args.in[7] + (size_t)l * HD, args.in[8] + (size_t)l * HD, RSVS, (LAS float*)(lds + EPISCR_OFF), (const float*)(ws + WS_RS8A) + (size_t)l * T, (const LAS float*)(lds + RS_OFF)};
            pg8::gemm_phase<pg8::EpiInProj1, pg8::DenseOrder, false, 2>(lds, D, S, E);
            SEAM(pb + 1);
        }
        if (IN(pb + 3)) {
            for (int rep_ = 0; rep_ < ((PROBE_REPEAT & 4) ? 2 : 1); ++rep_) {
            if (G == 256) {
                const int rank = (int)blockIdx.x >> 4;
                const int ngu = (int)((0x5444332221110000ull >> (4 * rank)) & 15ull);
                const int pre = (int)(((rank < 8 ? 0x0302010000000000ull : 0x1b17130f0c090705ull) >> (8 * (rank & 7))) & 255ull);
                if (rank >= 8) convert_pool(args, lds, (volatile LAS int*)(lds + MISC_OFF + 64), (unsigned*)(ws + WS_CTL) + CW_P0CTR + 256 + 64 * l, l == 0 ? NITEMS - NDEFER_W2 - NDEFER0 - NDEFER1 : NITEMS - NDEFER_W2 - NDEFER1, l == 0 ? NITEMS - NDEFER_W2 - NDEFER1 : NITEMS - NDEFER_W2, 21);
                for (int k = 0; k < ngu; ++k) { const int gu = 16 * (pre + k) + ((int)blockIdx.x & 15); gate_unit(lds, VSb, Ub, RSVS, args.in[9] + (size_t)l * SGW, (const bf16_t*)(ws + WS_WSB) + (size_t)l * 8 * 128 * 128, args.in[11] + (size_t)l * 8 * 128, YSG, gu >> 3, gu & 7); }
            } else
            for (int gu = blockIdx.x; gu < (T / 128) * 8; gu += G) gate_unit(lds, VSb, Ub, RSVS, args.in[9] + (size_t)l * SGW, (const bf16_t*)(ws + WS_WSB) + (size_t)l * 8 * 128 * 128, args.in[11] + (size_t)l * 8 * 128, YSG, gu >> 3, gu & 7);
            for (int a = blockIdx.x; a < NB * NH * (SEQ / 256); a += G) { const int bh = a & 15, qb = 15 - (a >> 4); att::unit(lds, Qb, Kb, Vb, YSB, bh >> 3, bh & 7, qb); }
            __syncthreads(); }
            { unsigned* cvctr = (unsigned*)(ws + WS_CTL) + CW_P0CTR + 256 + 64 * l; const int cvfirst = l == 0 ? NITEMS - NDEFER_W2 - NDEFER0 - NDEFER1 : NITEMS - NDEFER_W2 - NDEFER1, cvlast = l == 0 ? NITEMS - NDEFER_W2 - NDEFER1 : NITEMS - NDEFER_W2;
              convert_pool(args, lds, (volatile LAS int*)(lds + MISC_OFF + 64), cvctr, cvfirst, cvlast, G == 256 ? (((int)blockIdx.x >> 4) < 8 ? 18 : 0) : CV_MID);
              { pg8::DynOrder S{(const char*)(ws + WS_HN8A + (size_t)l * T * D), (const char*)(ws + WS_WIN) + (size_t)l * NIN * D, (unsigned*)(ws + WS_CTL) + CW_DYN + 512 * l, (volatile LAS int*)(lds + MISC_OFF + 80), (int)(xb_xcc_id() & 7u), 0, (size_t)256 * D, (size_t)256 * D, pg8::DYN_PN0 + lo, 0x7fffffff, 0};
                pg8::EpiInProj E{Qb, GAb, (const float*)(ws + WS_RS8A) + (size_t)l * T, (const LAS float*)(lds + RS_OFF)};
                pg8::gemm_phase<pg8::EpiInProj, pg8::DynOrder, false, 2>(lds, D, S, E); }
              convert_pool(args, lds, (volatile LAS int*)(lds + MISC_OFF + 64), cvctr, cvfirst, cvlast); }
            SEAM(pb + 3);
        }
        if (IN(pb + 4)) {
            pg8::PairOrder S{(const char*)YSB, (const char*)(ws + WS_WPSB) + (size_t)l * D * SBW * 2, (const char*)YSG, (const char*)(ws + WS_WPSG) + (size_t)l * D * SGW * 2, T / 256, D / 256, G, (int)blockIdx.x, (size_t)256 * SBW * 2, (size_t)256 * SBW * 2, GSH(1)};
            pg8::EpiProjMerge E{GAb, GBb, (float*)(ws + WS_TMPF), MRG};
            pg8::gemm_phase<pg8::EpiProjMerge, pg8::PairOrder, false>(lds, 2 * SBW, S, E);
            SEAM(pb + 4);
        }
        if (IN(pb + 5)) {
            pg8::DenseOrder S{(const char*)MRG, (const char*)(ws + WS_WOUT) + (size_t)l * D * D * 2, T / 256, D / 256, G, (int)blockIdx.x, (size_t)256 * D * 2, (size_t)256 * D * 2, GSH(2)};
            pg8::EpiResid<l != 0> E{xin, mod + 2 * D, X1, 1.0f};
            pg8::gemm_phase<pg8::EpiResid<l != 0>, pg8::DenseOrder, false>(lds, 2 * D, S, E);
            SEAM(pb + 5);
        }
        if constexpr (l == 0) {
            if (IN(pb + 6)) { norm_phase<false, true, true>(X1, args.in[5] + (size_t)l * D, mod + 3 * D, mod + 4 * D, (bf16_t*)(ws + WS_HN8), nullptr, ws, lds, G, (float*)(ws + WS_RS8)); SEAM(pb + 6); }
            if (IN(pb + 7)) {
                pg8::DenseOrder S{(const char*)(ws + WS_HN8), (const char*)(ws + WS_WF13), T / 256, 2 * FD / 256, G, (int)blockIdx.x, (size_t)256 * D, (size_t)256 * D, GSH(3)};
                pg8::EpiGLU<FFN0_F8 != 0, true> E{(void*)(ws + WS_HID), FD, 1.0f / WI8_SCALE, FFN0_F8 ? HID8_SCALE : 1.0f, (const float*)(ws + WS_RS8), nullptr, nullptr, (const LAS float*)(lds + RS_OFF)};
                pg8::gemm_phase<pg8::EpiGLU<FFN0_F8 != 0, true>, pg8::DenseOrder, false, 2>(lds, D, S, E);
                if (G != 256 || (int)blockIdx.x >= 128)
                    convert_pool(args, lds, (volatile LAS int*)(lds + MISC_OFF + 64), (unsigned*)(ws + WS_CTL) + CW_P0CTR + 192, NITEMS - NDEFER, NITEMS - NDEFER + NDEFER_DU, G == 256 ? 6 : 0x7fffffff);
                SEAM(pb + 7);
            }
            if (IN(pb + 8)) {
                constexpr int HB = FFN0_F8 ? 1 : 2;
                pg8::DenseOrder S{(const char*)(ws + WS_HID), (const char*)(ws + WS_WF2), T / 256, D / 256, G, (int)blockIdx.x, (size_t)256 * FD * HB, (size_t)256 * FD * HB, GSH(4)};
                pg8::EpiResid<true> E{X1, mod + 5 * D, X2, FFN0_F8 ? 1.0f / (W8_SCALE * HID8_SCALE) : 1.0f};
                pg8::gemm_phase<pg8::EpiResid<true>, pg8::DenseOrder, false, FFN0_F8 ? 1 : 0>(lds, HB * FD, S, E);
                SEAM(pb + 8);
            }
        } else {
            if (IN(pb + 6)) { norm_phase<true, true, true>(X1, args.in[5] + (size_t)l * D, mod + 3 * D, mod + 4 * D, (bf16_t*)(ws + WS_HN8), args.in[18], ws, lds, G, (float*)(ws + WS_RS8)); SEAM(pb + 6); }
            if (IN(pb + 7)) {
                moe_tables(ws, moetab);
                const int Gg = G == 256 ? G - MOEUP_CONV : G;
                if ((int)blockIdx.x >= Gg) convert_pool(args, lds, (volatile LAS int*)(lds + MISC_OFF + 64), (unsigned*)(ws + WS_CTL) + CW_P0CTR + 448, NITEMS - NDEFER_W2, NITEMS);
                pg8::MoeOrder S{(const char*)(ws + WS_HN8), (const char*)(ws + WS_WM13), (const int*)(ws + WS_ROUTE + (size_t)T * 24), moetab, 2 * FE / 256, Gg, (int)blockIdx.x, 1, (size_t)256 * D, (size_t)256 * D, (size_t)2 * FE * D, GSH(5)};
                pg8::EpiGLU<true, true> E{(void*)(ws + WS_HIDM), FE, 1.0f / WI8_SCALE, HID8_SCALE, (const float*)(ws + WS_RS8), (const int*)(ws + WS_ROUTE + (size_t)T * 24), (const float*)(ws + WS_ROUTE + 512 * 1024), (const LAS float*)(lds + RS_OFF)};
                if ((int)blockIdx.x < Gg) pg8::gemm_phase<pg8::EpiGLU<true, true>, pg8::MoeOrder, true, 2>(lds, D, S, E);
                convert_pool(args, lds, (volatile LAS int*)(lds + MISC_OFF + 64), (unsigned*)(ws + WS_CTL) + CW_P0CTR + 448, NITEMS - NDEFER_W2, NITEMS);
                SEAM(pb + 7);
            }
            if (IN(pb + 8)) {
                moe_tables(ws, moetab);
                pg8::MoeSplitOrder S{(const char*)(ws + WS_HIDM), (const char*)(ws + WS_WM2), moetab, D / 256, G, (int)blockIdx.x, FE / 128, (size_t)256 * FE, (size_t)256 * FE, (size_t)D * FE};
                pg8::EpiStore32Split E{(bf16_t*)(ws + WS_YM), D, 1.0f / (W8_SCALE * HID8_SCALE), (float*)(ws + WS_TMPF)};
                pg8::gemm_phase<pg8::EpiStore32Split, pg8::MoeSplitOrder, false, 1>(lds, FE, S, E);
                SEAM(pb + 8);
            }
            if (IN(pb + 9)) { moe_tables(ws, moetab); combine_phase(X1, mod + 5 * D, (const bf16_t*)(ws + WS_YM), (const float*)(ws + WS_TMPF), args.out, ws, moetab, G); }
        }

}
constexpr int NPHASE = 21;
__global__ void __launch_bounds__(NTHREADS, 2) fwd_kernel(Args args) {
    extern __shared__ __attribute__((aligned(16))) unsigned char lds_raw[];
    LAS unsigned char* lds = (LAS unsigned char*)lds_raw;
    volatile LAS unsigned* MISC = (volatile LAS unsigned*)(lds + MISC_OFF);
    volatile LAS int* moetab = (volatile LAS int*)(lds + MOETAB_OFF);
    const int tid = threadIdx.x, lane = tid & 63, wave = __builtin_amdgcn_readfirstlane(tid >> 6);
    const int G = gridDim.x;
    unsigned char* ws = args.ws;
    unsigned* ctl = (unsigned*)(ws + WS_CTL);
    for (int u = tid; u < (LDS_BYTES - LDSCTL_OFF) / 4; u += NTHREADS) ((LAS unsigned*)(lds + LDSCTL_OFF))[u] = 0u;
    __syncthreads();
    const int lo = args.ph_lo, hi = args.ph_hi;
    XcdBarrier bar; bar.bar = ctl + CW_BAR; bar.x = 0; bar.st = nullptr;
    if (hi - lo > 1) bar = xcd_barrier_post(ctl + CW_BAR, MISC + 8);

    if (IN(0)) {
        LAS float* cact = (LAS float*)(lds + 73728);
        LAS float* red = (LAS float*)(lds + 73728 + 16384);
        for (int i = tid; i < NB * D; i += NTHREADS) cact[i] = silu_f(args.in[1][i]);
        LDS_WAIT(); __syncthreads();
        for (int ai = blockIdx.x; ai < N_ADA_ITEMS; ai += G) p0_adaln_item(args, ai, cact, red, tid);
        for (int rep_ = 0; rep_ < ((PROBE_REPEAT & 1) ? 2 : 1); ++rep_) {
            convert_pool(args, lds, (volatile LAS int*)(MISC + 16), ctl + CW_P0CTR + 64 * rep_, 0, NITEMS - NDEFER);
        }
        { bf16_t* wsb = (bf16_t*)(ws + WS_WSB); const float* w_s = args.in[10];
          for (int i = blockIdx.x * NTHREADS + tid; i < NL * 8 * 128 * 128; i += G * NTHREADS) { const int s = i & 127, t = (i >> 7) & 127; wsb[i] = (bf16_t)(cvt_pk_bf16(s <= t ? w_s[i] : 0.f, 0.f) & 0xffffu); } }
        SEAM(0);
    }

    layer_phases<0>(args, lds, moetab, bar, lo, hi, G);
    layer_phases<1>(args, lds, moetab, bar, lo, hi, G);
#undef IN
#undef SEAM
}

extern "C" void kernel_launch(void* const* d_in, const int* in_sizes, int n_in, void* d_out, int out_size, void* d_ws, size_t ws_size, hipStream_t stream) {
    static int grid = 0;
    if (grid == 0) {
        if (n_in != 22 || out_size != T * D || ws_size < WS_END) { fprintf(stderr, "kernel_launch: unexpected shapes (n_in %d out %d ws %zu, need ws >= %zu); nothing launched\n", n_in, out_size, ws_size, (size_t)WS_END); grid = -1; return; }
        int dev = 0, cus = 0, per_cu = 0;
        if (hipGetDevice(&dev) != hipSuccess || hipDeviceGetAttribute(&cus, hipDeviceAttributeMultiprocessorCount, dev) != hipSuccess) { grid = -1; return; }
        if (hipFuncSetAttribute((const void*)fwd_kernel, hipFuncAttributeMaxDynamicSharedMemorySize, LDS_BYTES) != hipSuccess) { fprintf(stderr, "kernel_launch: hipFuncSetAttribute failed\n"); grid = -1; return; }
        if (hipOccupancyMaxActiveBlocksPerMultiprocessor(&per_cu, (const void*)fwd_kernel, NTHREADS, LDS_BYTES) != hipSuccess || per_cu < 1) { fprintf(stderr, "kernel_launch: occupancy query says %d blocks per CU\n", per_cu); }
        (void)hipGetLastError();
        grid = cus;
    }
    if (grid < 0) return;
    (void)hipMemsetAsync((char*)d_ws + WS_CTL, 0, CTL_ZERO_BYTES, stream);
    Args a{};
    for (int i = 0; i < 22; ++i) a.in[i] = (const float*)d_in[i];
    a.out = (float*)d_out; a.ws = (unsigned char*)d_ws;
#if MK_PER_PHASE
    for (int p = 0; p < NPHASE; ++p) { if (p == 10 || p == 3 || p == 13) continue; a.ph_lo = p; a.ph_hi = p + 1; hipLaunchKernelGGL(fwd_kernel, dim3(grid), dim3(NTHREADS), LDS_BYTES, stream, a); }
#else
    a.ph_lo = 0; a.ph_hi = NPHASE;
    hipLaunchKernelGGL(fwd_kernel, dim3(grid), dim3(NTHREADS), LDS_BYTES, stream, a);
#endif
    const hipError_t le = hipPeekAtLastError();
    if (le != hipSuccess) fprintf(stderr, "kernel_launch: launch failed: %s\n", hipGetErrorName(le));
}
```
